# Optimizing an MI355X kernel written in HIP

```python
import math
import jax, jax.numpy as jnp
from jax import lax
import numpy as np

D_MODEL = 1024
BATCH = 8
SEQ = 4096
DEPTH = 4
DEC_BATCH = 4
DEC_SEQ = 8192
PAST_LEN = 128

N_HEADS = 4
HEAD_DIM = 64
V_DIM = 2 * HEAD_DIM
D_QK = N_HEADS * 2 * HEAD_DIM
D_ATTN = N_HEADS * V_DIM
ROPE_THETA = 10000.0
Q_BLOCK = 128
D_SSM = 512
GROUP_CH = 16
N_GROUPS = D_SSM // GROUP_CH
N_STATE = 64
DT_MIN = 0.001
DT_MAX = 0.1
D_FF = -(-8 * D_MODEL // (3 * 256)) * 256
EPS = 1e-6

OFF_Q = 0
OFF_K = OFF_Q + D_QK
OFF_V = OFF_K + D_QK
OFF_U = OFF_V + D_ATTN
OFF_GA = OFF_U + D_SSM
OFF_GS = OFF_GA + D_MODEL
IN_COLS = OFF_GS + D_MODEL

kernel_name = 'hybrid_diffattn_s5_encoder'


def rms_norm(x, g):
    x32 = x.astype(jnp.float32)
    y = x32 * lax.rsqrt(jnp.mean(x32 * x32, axis=-1, keepdims=True) + EPS)
    return (y * g.astype(jnp.float32)).astype(x.dtype)


def rope_tables(seq_len):
    inv = 1.0 / (ROPE_THETA ** (jnp.arange(0, HEAD_DIM, 2, dtype=jnp.float32) / HEAD_DIM))
    ang = jnp.arange(seq_len, dtype=jnp.float32)[:, None] * inv[None, :]
    ang = jnp.concatenate([ang, ang], axis=-1)
    return jnp.cos(ang), jnp.sin(ang)


def apply_rope(x, cos, sin):
    x1, x2 = jnp.split(x, 2, axis=-1)
    rot = jnp.concatenate([-x2, x1], axis=-1)
    c = cos[None, :, None, None, :]
    s = sin[None, :, None, None, :]
    return (x.astype(jnp.float32) * c + rot.astype(jnp.float32) * s).astype(x.dtype)


def lambda_init_fn(layer):
    return 0.8 - 0.6 * math.exp(-0.3 * layer)


def diff_attention(q, k, v, lam):
    b, l, h, _, d = q.shape
    nb = l // Q_BLOCK
    scale = HEAD_DIM ** -0.5
    qb = q.reshape(b, nb, Q_BLOCK, h, 2, d).transpose(1, 0, 2, 3, 4, 5)

    def one_block(q_blk):
        s = jnp.einsum('bqhmd,bkhmd->bhmqk', q_blk, k).astype(jnp.float32) * scale
        p = jax.nn.softmax(s, axis=-1)
        a = p[:, :, 0] - lam * p[:, :, 1]
        return jnp.einsum('bhqk,bkhe->bqhe', a.astype(v.dtype), v)

    out = lax.map(one_block, qb)
    return out.transpose(1, 0, 2, 3, 4).reshape(b, l, h, V_DIM)


def zoh(a_re, a_im, log_dt, b_re, b_im):
    dt = jnp.exp(log_dt.astype(jnp.float32))[:, None]
    ar = a_re.astype(jnp.float32)
    ai = a_im.astype(jnp.float32)
    mag = jnp.exp(dt * ar)
    abr = mag * jnp.cos(dt * ai)
    abi = mag * jnp.sin(dt * ai)
    nr = abr - 1.0
    ni = abi
    den = ar * ar + ai * ai
    fr = (nr * ar + ni * ai) / den
    fi = (ni * ar - nr * ai) / den
    br = b_re.astype(jnp.float32)
    bi = b_im.astype(jnp.float32)
    bbr = fr[..., None] * br - fi[..., None] * bi
    bbi = fr[..., None] * bi + fi[..., None] * br
    return abr, abi, bbr, bbi


def complex_affine_combine(e1, e2):
    a1r, a1i, b1r, b1i = e1
    a2r, a2i, b2r, b2i = e2
    return (a1r * a2r - a1i * a2i,
            a1r * a2i + a1i * a2r,
            a2r * b1r - a2i * b1i + b2r,
            a2r * b1i + a2i * b1r + b2i)


def ssm_direction(u32, a_re, a_im, log_dt, b_re, b_im, c_re, c_im, reverse):
    abr, abi, bbr, bbi = zoh(a_re, a_im, log_dt, b_re, b_im)
    bur = jnp.einsum('blgc,gpc->blgp', u32, bbr)
    bui = jnp.einsum('blgc,gpc->blgp', u32, bbi)
    shape = (1, u32.shape[1]) + abr.shape
    ar_t = jnp.broadcast_to(abr, shape)
    ai_t = jnp.broadcast_to(abi, shape)
    _, _, hr, hi = lax.associative_scan(complex_affine_combine, (ar_t, ai_t, bur, bui),
                                        reverse=reverse, axis=1)
    return (jnp.einsum('blgp,gcp->blgc', hr, c_re.astype(jnp.float32))
            - jnp.einsum('blgp,gcp->blgc', hi, c_im.astype(jnp.float32)))


def ssm_branch(u, a_re, a_im, log_dt, b_re, b_im, c_re, c_im, d_skip, w_glu, b_glu):
    b, l, _ = u.shape
    u32 = u.astype(jnp.float32)
    ug = u32.reshape(b, l, N_GROUPS, GROUP_CH)
    y = (ssm_direction(ug, a_re[0], a_im[0], log_dt[0], b_re[0], b_im[0], c_re[0], c_im[0], False)
         + ssm_direction(ug, a_re[1], a_im[1], log_dt[1], b_re[1], b_im[1], c_re[1], c_im[1], True))
    y = y.reshape(b, l, D_SSM) + d_skip.astype(jnp.float32) * u32
    z = jax.nn.gelu(y).astype(u.dtype)
    lin, gate = jnp.split(z @ w_glu + b_glu, 2, axis=-1)
    return lin * jax.nn.sigmoid(gate)


def layer(x, c, cos, sin, lam_init, w_mod, b_mod, norm1_g, w_in, lam_q1, lam_k1, lam_q2, lam_k2,
          subln_g, w_attn_br, ssm_a_re, ssm_a_im, ssm_log_dt, ssm_b_re, ssm_b_im, ssm_c_re, ssm_c_im,
          ssm_d, w_glu, b_glu, w_o, norm2_g, w_ffn_in, w_ffn_out):
    b, l, _ = x.shape
    mod = jax.nn.silu(c) @ w_mod + b_mod
    sh1, sc1, gt1, sh2, sc2, gt2 = jnp.split(mod[:, None, :], 6, axis=-1)

    h = rms_norm(x, norm1_g) * (1 + sc1) + sh1
    proj = h @ w_in
    q = proj[..., OFF_Q:OFF_K].reshape(b, l, N_HEADS, 2, HEAD_DIM)
    k = proj[..., OFF_K:OFF_V].reshape(b, l, N_HEADS, 2, HEAD_DIM)
    v = proj[..., OFF_V:OFF_U].reshape(b, l, N_HEADS, V_DIM)
    u = proj[..., OFF_U:OFF_GA]
    g_a = proj[..., OFF_GA:OFF_GS]
    g_s = proj[..., OFF_GS:IN_COLS]

    q = apply_rope(q, cos, sin)
    k = apply_rope(k, cos, sin)
    lam = (jnp.exp(jnp.sum(lam_q1.astype(jnp.float32) * lam_k1.astype(jnp.float32)))
           - jnp.exp(jnp.sum(lam_q2.astype(jnp.float32) * lam_k2.astype(jnp.float32)))
           + lam_init)
    o = diff_attention(q, k, v, lam)
    o = rms_norm(o, subln_g) * (1.0 - lam_init)
    y_attn = o.reshape(b, l, D_ATTN) @ w_attn_br

    y_ssm = ssm_branch(u, ssm_a_re, ssm_a_im, ssm_log_dt, ssm_b_re, ssm_b_im, ssm_c_re, ssm_c_im,
                       ssm_d, w_glu, b_glu)

    merged = jax.nn.sigmoid(g_a) * y_attn + jax.nn.sigmoid(g_s) * y_ssm
    x = x + gt1 * (merged @ w_o)

    h2 = rms_norm(x, norm2_g) * (1 + sc2) + sh2
    f_gate, f_up = jnp.split(h2 @ w_ffn_in, 2, axis=-1)
    x = x + gt2 * ((jax.nn.silu(f_gate) * f_up) @ w_ffn_out)
    return x


def trunk(x, c, w_mod, b_mod, norm1_g, w_in, lam_q1, lam_k1, lam_q2, lam_k2, subln_g, w_attn_br,
          ssm_a_re, ssm_a_im, ssm_log_dt, ssm_b_re, ssm_b_im, ssm_c_re, ssm_c_im, ssm_d, w_glu, b_glu,
          w_o, norm2_g, w_ffn_in, w_ffn_out, final_g):
    cos, sin = rope_tables(x.shape[1])
    for i in range(DEPTH):
        x = layer(x, c, cos, sin, lambda_init_fn(i), w_mod[i], b_mod[i], norm1_g[i], w_in[i],
                  lam_q1[i], lam_k1[i], lam_q2[i], lam_k2[i], subln_g[i], w_attn_br[i],
                  ssm_a_re[i], ssm_a_im[i], ssm_log_dt[i], ssm_b_re[i], ssm_b_im[i],
                  ssm_c_re[i], ssm_c_im[i], ssm_d[i], w_glu[i], b_glu[i], w_o[i], norm2_g[i],
                  w_ffn_in[i], w_ffn_out[i])
    return rms_norm(x, final_g)


def setup_inputs(seed: int = 0) -> dict:
    key = jax.random.key(seed)
    ks = jax.random.split(key, 32)
    f32 = jnp.float32

    def nrm(k, shape, scale):
        return jax.random.normal(k, shape, f32) * scale

    n = jnp.arange(N_STATE, dtype=f32)
    ssm_a_re = -0.5 + nrm(ks[12], (DEPTH, 2, N_GROUPS, N_STATE), 0.01)
    ssm_a_im = math.pi * n + nrm(ks[13], (DEPTH, 2, N_GROUPS, N_STATE), 0.01)
    ssm_log_dt = jax.random.uniform(ks[14], (DEPTH, 2, N_GROUPS), f32,
                                    minval=math.log(DT_MIN), maxval=math.log(DT_MAX))
    return {
        'x_prompt': nrm(ks[0], (BATCH, SEQ, D_MODEL), 1.0),
        'x_sample': nrm(ks[1], (DEC_BATCH, DEC_SEQ, D_MODEL), 1.0),
        'c_prompt': nrm(ks[2], (BATCH, D_MODEL), 1.0),
        'c_sample': nrm(ks[3], (DEC_BATCH, D_MODEL), 1.0),
        'w_mod': nrm(ks[4], (DEPTH, D_MODEL, 6 * D_MODEL), 0.5 * D_MODEL ** -0.5),
        'b_mod': nrm(ks[5], (DEPTH, 6 * D_MODEL), 0.01),
        'norm1_g': 1.0 + nrm(ks[6], (DEPTH, D_MODEL), 0.02),
        'w_in': nrm(ks[7], (DEPTH, D_MODEL, IN_COLS), D_MODEL ** -0.5),
        'lam_q1': nrm(ks[8], (DEPTH, HEAD_DIM), 0.1),
        'lam_k1': nrm(ks[9], (DEPTH, HEAD_DIM), 0.1),
        'lam_q2': nrm(ks[10], (DEPTH, HEAD_DIM), 0.1),
        'lam_k2': nrm(ks[11], (DEPTH, HEAD_DIM), 0.1),
        'subln_g': 1.0 + nrm(ks[15], (DEPTH, V_DIM), 0.02),
        'w_attn_br': nrm(ks[16], (DEPTH, D_ATTN, D_MODEL), D_ATTN ** -0.5),
        'ssm_a_re': ssm_a_re,
        'ssm_a_im': ssm_a_im,
        'ssm_log_dt': ssm_log_dt,
        'ssm_b_re': nrm(ks[17], (DEPTH, 2, N_GROUPS, N_STATE, GROUP_CH), (2 * GROUP_CH) ** -0.5),
        'ssm_b_im': nrm(ks[18], (DEPTH, 2, N_GROUPS, N_STATE, GROUP_CH), (2 * GROUP_CH) ** -0.5),
        'ssm_c_re': nrm(ks[19], (DEPTH, 2, N_GROUPS, GROUP_CH, N_STATE), (2 * N_STATE) ** -0.5),
        'ssm_c_im': nrm(ks[20], (DEPTH, 2, N_GROUPS, GROUP_CH, N_STATE), (2 * N_STATE) ** -0.5),
        'ssm_d': nrm(ks[21], (DEPTH, D_SSM), 1.0),
        'w_glu': nrm(ks[22], (DEPTH, D_SSM, 2 * D_MODEL), D_SSM ** -0.5),
        'b_glu': nrm(ks[23], (DEPTH, 2 * D_MODEL), 0.01),
        'w_o': nrm(ks[24], (DEPTH, D_MODEL, D_MODEL), D_MODEL ** -0.5),
        'norm2_g': 1.0 + nrm(ks[25], (DEPTH, D_MODEL), 0.02),
        'w_ffn_in': nrm(ks[26], (DEPTH, D_MODEL, 2 * D_FF), D_MODEL ** -0.5),
        'w_ffn_out': nrm(ks[27], (DEPTH, D_FF, D_MODEL), D_FF ** -0.5),
        'final_g': 1.0 + nrm(ks[28], (D_MODEL,), 0.02),
    }


def reference(x_prompt, x_sample, c_prompt, c_sample, w_mod, b_mod, norm1_g, w_in,
              lam_q1, lam_k1, lam_q2, lam_k2, subln_g, w_attn_br, ssm_a_re, ssm_a_im,
              ssm_log_dt, ssm_b_re, ssm_b_im, ssm_c_re, ssm_c_im, ssm_d, w_glu, b_glu,
              w_o, norm2_g, w_ffn_in, w_ffn_out, final_g):
    params = (w_mod, b_mod, norm1_g, w_in, lam_q1, lam_k1, lam_q2, lam_k2, subln_g, w_attn_br,
              ssm_a_re, ssm_a_im, ssm_log_dt, ssm_b_re, ssm_b_im, ssm_c_re, ssm_c_im, ssm_d,
              w_glu, b_glu, w_o, norm2_g, w_ffn_in, w_ffn_out, final_g)
    y_prompt = trunk(x_prompt, c_prompt, *params)
    y_sample = trunk(x_sample, c_sample, *params)
    return (y_prompt, y_sample)
```

```cpp
#include <hip/hip_runtime.h>
#include <hip/hip_cooperative_groups.h>
#include <cstdio>
#include <cstdint>
namespace cg = cooperative_groups;

#define LAS __attribute__((address_space(3)))
typedef unsigned short bf16_t;
typedef short bf16x8 __attribute__((ext_vector_type(8)));
typedef short s16x4 __attribute__((ext_vector_type(4)));
typedef float f32x4 __attribute__((ext_vector_type(4)));
typedef float f32x2 __attribute__((ext_vector_type(2)));
typedef float f32x16 __attribute__((ext_vector_type(16)));
typedef unsigned u32x4 __attribute__((ext_vector_type(4)));
typedef unsigned u32x2 __attribute__((ext_vector_type(2)));

constexpr int D = 1024, DEPTH = 4, DFF = 2816, INCOLS = 4096;
constexpr int MG = 32768;
constexpr int NROW = MG / 16;
constexpr float EPS = 1e-6f;
constexpr float QSC = 0.125f * 1.4426950408889634f;
constexpr int NTHREADS = 512, NWAVES = 8;

constexpr size_t MiB = 1u << 20;
constexpr size_t WS_MOD = 0;
constexpr size_t WS_ROPE = 2 * MiB;
constexpr size_t WS_A16 = 4 * MiB;
constexpr size_t WS_WIN = 5 * MiB;
constexpr size_t WS_WATT = 13 * MiB;
constexpr size_t WS_WGLU = 14 * MiB;
constexpr size_t WS_WO = 16 * MiB;
constexpr size_t WS_WFI = 18 * MiB;
constexpr size_t WS_WFO = 29 * MiB;
constexpr size_t WS_BTS = 35 * MiB;
constexpr size_t WS_BTY = 39 * MiB;
constexpr size_t WS_STASH = 47 * MiB;
constexpr size_t WS_H = 111 * MiB;
constexpr size_t WS_Q = 175 * MiB;
constexpr size_t WS_K = 207 * MiB;
constexpr size_t WS_V = 239 * MiB;
constexpr size_t WS_SSMA = 271 * MiB;
constexpr size_t WS_GA = 335 * MiB;
constexpr size_t WS_GS = 399 * MiB;
constexpr size_t WS_ACT = 175 * MiB;
constexpr size_t WS_END = 463 * MiB;
constexpr size_t WS_BAR = 4 * MiB + 768 * 1024;
constexpr int LDS_MISC = 131072;
constexpr int LDS_BYTES = 135168;

struct Args { const float* in[29]; float* out; unsigned char* ws; };

__device__ __forceinline__ int fresh_lane() { int l; asm volatile("v_mbcnt_lo_u32_b32 %0, -1, 0\n\tv_mbcnt_hi_u32_b32 %0, -1, %0" : "=v"(l)); return l; }
__device__ __forceinline__ int fresh_tid(int wave) { return wave * 64 + fresh_lane(); }
typedef __attribute__((address_space(1))) unsigned char gas_u8;
__device__ __forceinline__ unsigned char* fresh_ptr(unsigned char* p) { gas_u8* g = (gas_u8*)p; asm volatile("" : "+s"(g)); return (unsigned char*)g; }
typedef __bf16 bf16x2_t __attribute__((ext_vector_type(2)));
__device__ __forceinline__ unsigned cvt_pk_bf16(float lo, float hi) { const f32x2 v = {lo, hi}; const bf16x2_t b = __builtin_convertvector(v, bf16x2_t); return __builtin_bit_cast(unsigned, b); }
__device__ __forceinline__ float bf2f(unsigned short b) { return __uint_as_float(((unsigned)b) << 16); }
__device__ __forceinline__ float bflo(unsigned w) { return __uint_as_float(w << 16); }
__device__ __forceinline__ float bfhi(unsigned w) { return __uint_as_float(w & 0xffff0000u); }
__device__ __forceinline__ float sigmoidf_(float x) { return __builtin_amdgcn_rcpf(1.0f + __expf(-x)); }
__device__ __forceinline__ float siluf_(float x) { return x * __builtin_amdgcn_rcpf(1.0f + __expf(-x)); }
__device__ __forceinline__ float gelu_tanh(float y) { const float z = 0.7978845608028654f * (y + 0.044715f * y * y * y); const float t = 1.0f - 2.0f * __builtin_amdgcn_rcpf(1.0f + __expf(2.0f * z)); return 0.5f * y * (1.0f + t); }
template <int M> __device__ __forceinline__ float swz_xor(float v) { return __int_as_float(__builtin_amdgcn_ds_swizzle(__float_as_int(v), (M << 10) | 0x1f)); }
__device__ __forceinline__ float half_sum(float v) { v += swz_xor<1>(v); v += swz_xor<2>(v); v += swz_xor<4>(v); v += swz_xor<8>(v); v += swz_xor<16>(v); return v; }
__device__ __forceinline__ float wave_sum(float v) {
    v = half_sum(v);
    auto rr = __builtin_amdgcn_permlane32_swap(__float_as_uint(v), __float_as_uint(v), false, false);
    return __uint_as_float(rr[0]) + __uint_as_float(rr[1]);
}
__device__ __forceinline__ u32x4 pack8(f32x4 a, f32x4 b) { u32x4 w; w.x = cvt_pk_bf16(a[0], a[1]); w.y = cvt_pk_bf16(a[2], a[3]); w.z = cvt_pk_bf16(b[0], b[1]); w.w = cvt_pk_bf16(b[2], b[3]); return w; }

namespace pg8 {
constexpr int BM = 256, BK = 64, HALF = 128, HTB = HALF * BK * 2, STAGE_BYTES = 8 * HTB, NXCD = 8, WGM = 8;
__host__ __device__ __forceinline__ int lds_byte(int r, int c) { const int st = (r >> 4) * 2 + (c >> 5), rr = r & 15, cc = c & 31, ob = rr * 64 + cc * 2; return st * 1024 + (ob ^ (((ob >> 9) & 1) << 5)); }
__host__ __device__ __forceinline__ void stage_rc(int b, int& R, int& C) { const int st = b / 1024, sb = b % 1024, swz = sb ^ (((sb >> 9) & 1) << 5); R = (st >> 1) * 16 + swz / 64; C = (st & 1) * 32 + (swz % 64) / 2; }
__host__ __device__ __forceinline__ int perm32(int rho) { const int n = rho >> 4, i = rho & 15; return 8 * (i >> 2) + 4 * n + (i & 3); }
struct Unit { const char* a; const char* b; int pm, pn, aux; };
template <class Epi, class Sched>
__device__ __forceinline__ void gemm_phase(LAS unsigned char* lds, const int wid, const int K, const int lda, const int ldb, const Sched& S, const Epi& E) {
    const int lane = fresh_lane(), tid = wid * 64 + lane, wr = wid >> 2, wc = wid & 3, fr = lane & 15, fq = lane >> 4;
    const int nt = K / BK;
    unsigned voffA, voffB;
    { int R, C; stage_rc(tid * 16, R, C); const int Rb = Epi::PERM ? ((R & ~31) + perm32(R & 31)) : R;
      voffA = (unsigned)(R * lda + C) * 2u; voffB = (unsigned)(Rb * ldb + C) * 2u; }
    const size_t qvoffA = (size_t)64 * lda * 2, qvoffB = (size_t)64 * ldb * 2;
    const size_t kstep = (size_t)(BK * 2);
    const size_t hA = (size_t)HALF * lda * 2, hB = (size_t)HALF * ldb * 2;
    const unsigned ldsw = (unsigned)wid * 1024u;
    const int aoff = lds_byte(wr * 64 + fr, fq * 8), boff = lds_byte(wc * 32 + fr, fq * 8);
#define PG8_SA(b, h) (((b) * 2 + (h)) * HTB)
#define PG8_SB(b, h) ((4 + (b) * 2 + (h)) * HTB)
#define PG8_STAGE(bufoff, gbase, voff) do { _Pragma("unroll") for (int _i = 0; _i < 2; ++_i) \
        __builtin_amdgcn_global_load_lds((const unsigned*)((const char*)(gbase) + (size_t)_i * q##voff + (voff)), (LAS unsigned*)(lds + (bufoff) + ldsw + _i * 8192), 16, 0, 0); } while (0)
#define PG8_LDA(dst, b, h) do { _Pragma("unroll") for (int m = 0; m < 4; ++m) _Pragma("unroll") for (int k = 0; k < 2; ++k) dst[m][k] = *(const LAS bf16x8*)(lds + PG8_SA(b, h) + aoff + m * 2048 + k * 1024); } while (0)
#define PG8_LDB(dst, b, h) do { _Pragma("unroll") for (int n = 0; n < 2; ++n) _Pragma("unroll") for (int k = 0; k < 2; ++k) dst[n][k] = *(const LAS bf16x8*)(lds + PG8_SB(b, h) + boff + n * 2048 + k * 1024); } while (0)
#define PG8_MMA(ai, bj, At, Bt) do { __builtin_amdgcn_s_setprio(1); _Pragma("unroll") for (int m = 0; m < 4; ++m) _Pragma("unroll") for (int n = 0; n < 2; ++n) _Pragma("unroll") for (int k = 0; k < 2; ++k) \
        acc[ai][bj][m][n] = __builtin_amdgcn_mfma_f32_16x16x32_bf16(Bt[n][k], At[m][k], acc[ai][bj][m][n], 0, 0, 0); __builtin_amdgcn_s_setprio(0); } while (0)
#define PG8_WAIT_V(n) asm volatile("s_waitcnt vmcnt(" #n ")" ::: "memory")
#define PG8_WAIT_L(n) asm volatile("s_waitcnt lgkmcnt(" #n ")" ::: "memory")
#define PG8_BAR __builtin_amdgcn_s_barrier()
#define PG8_SCHED __builtin_amdgcn_sched_barrier(0)
    Unit cur, nxt; int ui = 0;
    if (!S.next(0, cur)) return;
    f32x4 acc[2][2][4][2];
#pragma unroll
    for (int a = 0; a < 2; ++a)
#pragma unroll
        for (int b = 0; b < 2; ++b)
#pragma unroll
            for (int m = 0; m < 4; ++m)
#pragma unroll
                for (int n = 0; n < 2; ++n) acc[a][b][m][n] = (f32x4){0.f, 0.f, 0.f, 0.f};
    bf16x8 At[4][2], B0[2][2], B1[2][2];
    const char* cA = cur.a; const char* cB = cur.b;
    PG8_STAGE(PG8_SB(0, 0), cB, voffB); PG8_STAGE(PG8_SB(0, 1), cB + hB, voffB); PG8_STAGE(PG8_SA(0, 0), cA, voffA); PG8_STAGE(PG8_SA(0, 1), cA + hA, voffA);
    if (wr == 1) PG8_BAR;
    PG8_WAIT_V(2); PG8_BAR;
    PG8_STAGE(PG8_SB(1, 0), cB + kstep, voffB); PG8_STAGE(PG8_SA(1, 0), cA + kstep, voffA); PG8_STAGE(PG8_SB(1, 1), cB + hB + kstep, voffB);
    PG8_WAIT_V(6); PG8_BAR;
    for (;;) {
        const bool has_next = S.next(ui + 1, nxt);
        const char* nA = has_next ? nxt.a : cA; const char* nB = has_next ? nxt.b : cB;
        for (int t = 0; t < nt; t += 2) {
            const bool last = (t == nt - 2);
            const char* a1 = cA + (size_t)(t + 1) * kstep;
            const char* a2 = last ? nA : cA + (size_t)(t + 2) * kstep; const char* b2 = last ? nB : cB + (size_t)(t + 2) * kstep;
            const char* a3 = a2 + kstep; const char* b3 = b2 + kstep;
            PG8_LDB(B0, 0, 0); PG8_LDB(B1, 0, 1); PG8_SCHED; PG8_LDA(At, 0, 0); PG8_STAGE(PG8_SA(1, 1), a1 + hA, voffA);
            PG8_WAIT_V(8); PG8_WAIT_L(0); PG8_BAR; PG8_MMA(0, 0, At, B0); PG8_MMA(0, 1, At, B1); PG8_BAR; PG8_SCHED;
            PG8_LDA(At, 0, 1); PG8_STAGE(PG8_SB(0, 0), b2, voffB); PG8_STAGE(PG8_SB(0, 1), b2 + hB, voffB); PG8_STAGE(PG8_SA(0, 0), a2, voffA);
            PG8_WAIT_V(8); PG8_WAIT_L(0); PG8_BAR; PG8_MMA(1, 0, At, B0); PG8_MMA(1, 1, At, B1); PG8_BAR; PG8_SCHED;
            PG8_LDB(B0, 1, 0); PG8_LDB(B1, 1, 1); PG8_SCHED; PG8_LDA(At, 1, 0); PG8_STAGE(PG8_SA(0, 1), a2 + hA, voffA);
            PG8_WAIT_V(8); PG8_WAIT_L(0); PG8_BAR; PG8_MMA(0, 0, At, B0); PG8_MMA(0, 1, At, B1); PG8_BAR; PG8_SCHED;
            PG8_LDA(At, 1, 1); PG8_STAGE(PG8_SB(1, 0), b3, voffB); PG8_STAGE(PG8_SB(1, 1), b3 + hB, voffB); PG8_STAGE(PG8_SA(1, 0), a3, voffA);
            PG8_WAIT_V(8); PG8_WAIT_L(0); PG8_BAR; PG8_MMA(1, 0, At, B0); PG8_MMA(1, 1, At, B1); PG8_BAR; PG8_SCHED;
        }
        if (wr == 0) PG8_BAR;
        E(acc, cur, wr, wc, fr, fq);
        if (!has_next) break;
#pragma unroll
        for (int a = 0; a < 2; ++a)
#pragma unroll
            for (int b = 0; b < 2; ++b)
#pragma unroll
                for (int m = 0; m < 4; ++m)
#pragma unroll
                    for (int n = 0; n < 2; ++n) acc[a][b][m][n] = (f32x4){0.f, 0.f, 0.f, 0.f};
        cur = nxt; cA = nA; cB = nB; ++ui;
        if (wr == 1) PG8_BAR;
    }
    PG8_WAIT_V(0);
    PG8_BAR;
#undef PG8_SA
#undef PG8_SB
#undef PG8_STAGE
#undef PG8_LDA
#undef PG8_LDB
#undef PG8_MMA
#undef PG8_WAIT_V
#undef PG8_WAIT_L
#undef PG8_BAR
#undef PG8_SCHED
}

struct GridOrder {
    int nM, nN, nwg, G, c; const char* A; const char* B; size_t ta, tb;
    __device__ void init(int M, int N, int G_, int c_, const void* A_, const void* B_, int lda, int ldb) { nM = M / BM; nN = N / BM; nwg = nM * nN; G = G_; c = c_; A = (const char*)A_; B = (const char*)B_; ta = (size_t)BM * lda * 2; tb = (size_t)BM * ldb * 2; }
    __device__ bool next(int i, Unit& u) const {
        const long L = (long)i * G + c; if (L >= nwg) return false;
        int wgid = (int)L; { const int q = nwg / NXCD, r = nwg % NXCD, xcd = wgid % NXCD, off = wgid / NXCD; wgid = (xcd < r ? xcd * (q + 1) : r * (q + 1) + (xcd - r) * q) + off; }
        const int nig = WGM * nN, gid = wgid / nig, fm = gid * WGM, gsz = (nM - fm) < WGM ? (nM - fm) : WGM;
        u.pm = fm + ((wgid % nig) % gsz); u.pn = (wgid % nig) / gsz; u.aux = 0;
        u.a = A + (size_t)u.pm * ta; u.b = B + (size_t)u.pn * tb; return true;
    }
};
struct SsmOrder {
    const char* A; const char* B; size_t tb; int G, c;
    __device__ bool next(int i, Unit& u) const {
        const int w = i * G + c; if (w >= 256) return false;
        u.pm = w; u.pn = 0; u.aux = 0; u.a = A + (size_t)w * 256 * 512 * 2; u.b = B + (size_t)(w >> 3) * tb; return true;
    }
};
struct MergeOrder {
    const char* Z; const char* ON; const char* WG; const char* WA; int G, c;
    __device__ bool next(int i, Unit& u) const {
        const int item = c + (i / 6) * G; if (item >= 256) return false;
        const int sub = i % 6, panel = item >> 1, half = item & 1, jj = half * 2 + sub / 3, t = sub % 3;
        u.pm = panel;
        if (t < 2) { const int gu = 2 * jj + t; u.pn = gu; u.aux = 0; u.a = Z + (size_t)panel * 256 * 512 * 2; u.b = WG + (size_t)gu * 256 * 512 * 2; }
        else { u.pn = jj; u.aux = 1; u.a = ON + (size_t)panel * 256 * 512 * 2; u.b = WA + (size_t)jj * 256 * 512 * 2; }
        return true;
    }
};
}
using pg8::Unit;
typedef f32x4 Acc[2][2][4][2];

struct EpiInproj {
    static constexpr bool PERM = true;
    bf16_t *Q, *Kb, *V, *SSMA, *GA, *GS; const float* rope; int Lmask;
    __device__ __forceinline__ void operator()(const Acc& acc, const Unit& u, int wr, int wc, int fr, int fq) const {
        { const int ln = fresh_lane(); fr = ln & 15; fq = ln >> 4; }
        const int reg = u.pn;
        if (reg < 4) {
            const int i0 = ((wc * 32 + fq * 8) & 63) >> 1;
            bf16_t* base = (reg < 2 ? Q + u.pn * 256 : Kb + (u.pn * 256 - 512)) + wc * 32 + fq * 8;
#pragma unroll
            for (int ai = 0; ai < 2; ++ai) {
                const int row0 = u.pm * 256 + ai * 128 + wr * 64 + fr;
                f32x4 r0[4], r1[4];
#pragma unroll
                for (int m = 0; m < 4; ++m) { const f32x4* rp = (const f32x4*)(rope + ((size_t)((row0 + m * 16) & Lmask) * 32 + i0) * 2); r0[m] = rp[0]; r1[m] = rp[1]; }
#pragma unroll
                for (int m = 0; m < 4; ++m) asm volatile("" : "+v"(r0[m]), "+v"(r1[m]));
#pragma unroll
                for (int m = 0; m < 4; ++m)
#pragma unroll
                    for (int bj = 0; bj < 2; ++bj) {
                        const f32x4 v0 = acc[ai][bj][m][0], v1 = acc[ai][bj][m][1];
                        f32x4 w0, w1;
                        w0[0] = v0[0] * r0[m][0] - v0[1] * r0[m][1]; w0[1] = v0[1] * r0[m][0] + v0[0] * r0[m][1];
                        w0[2] = v0[2] * r0[m][2] - v0[3] * r0[m][3]; w0[3] = v0[3] * r0[m][2] + v0[2] * r0[m][3];
                        w1[0] = v1[0] * r1[m][0] - v1[1] * r1[m][1]; w1[1] = v1[1] * r1[m][0] + v1[0] * r1[m][1];
                        w1[2] = v1[2] * r1[m][2] - v1[3] * r1[m][3]; w1[3] = v1[3] * r1[m][2] + v1[2] * r1[m][3];
                        if (reg < 2) { w0 = w0 * QSC; w1 = w1 * QSC; }
                        *(u32x4*)(base + (size_t)(row0 + m * 16) * 512 + bj * 128) = pack8(w0, w1);
                    }
            }
            return;
        }
#pragma unroll
        for (int ai = 0; ai < 2; ++ai)
#pragma unroll
            for (int m = 0; m < 4; ++m) {
                const int row = u.pm * 256 + ai * 128 + wr * 64 + m * 16 + fr;
#pragma unroll
                for (int bj = 0; bj < 2; ++bj) {
                    const int c0 = u.pn * 256 + bj * 128 + wc * 32 + fq * 8;
                    f32x4 v0 = acc[ai][bj][m][0], v1 = acc[ai][bj][m][1];
                    bf16_t* dst;
                    if (reg < 6) {
                        dst = V + (size_t)row * 512 + (c0 - 1024);
                    } else if (reg < 8) {
                        const int c = c0 - 1536, g = c >> 4, ch0 = c & 15;
                        dst = SSMA + ((size_t)(g * NROW + (row >> 4)) * 512 + (row & 15) * 16 + ch0);
                    } else {
#pragma unroll
                        for (int i = 0; i < 4; ++i) { v0[i] = sigmoidf_(v0[i]); v1[i] = sigmoidf_(v1[i]); }
                        dst = (reg < 12 ? GA + (c0 - 2048) : GS + (c0 - 3072)) + (size_t)row * 1024;
                    }
                    *(u32x4*)dst = pack8(v0, v1);
                }
            }
    }
};
struct EpiResid {
    static constexpr bool PERM = false;
    const float* xr; float* x; const float* gt; int Lshift;
    __device__ __forceinline__ void operator()(const Acc& acc, const Unit& u, int wr, int wc, int fr, int fq) const {
        { const int ln = fresh_lane(); fr = ln & 15; fq = ln >> 4; }
        const int col0 = u.pn * 256 + wc * 32 + fq * 4;
#pragma unroll
        for (int ai = 0; ai < 2; ++ai) {
            const int row0 = u.pm * 256 + ai * 128 + wr * 64 + fr; const int b = row0 >> Lshift;
            float* xp = x + (size_t)row0 * 1024 + col0; const float* xq = xr + (size_t)row0 * 1024 + col0;
            f32x4 xv[4][2][2], g4[2][2];
#pragma unroll
            for (int bj = 0; bj < 2; ++bj)
#pragma unroll
                for (int n = 0; n < 2; ++n) g4[bj][n] = *(const f32x4*)(gt + (size_t)b * 6144 + col0 + bj * 128 + n * 16);
#pragma unroll
            for (int m = 0; m < 4; ++m)
#pragma unroll
                for (int bj = 0; bj < 2; ++bj)
#pragma unroll
                    for (int n = 0; n < 2; ++n) xv[m][bj][n] = *(const f32x4*)(xq + (size_t)m * 16 * 1024 + bj * 128 + n * 16);
#pragma unroll
            for (int m = 0; m < 4; ++m)
#pragma unroll
                for (int bj = 0; bj < 2; ++bj)
#pragma unroll
                    for (int n = 0; n < 2; ++n) asm volatile("" : "+v"(xv[m][bj][n]));
#pragma unroll
            for (int m = 0; m < 4; ++m)
#pragma unroll
                for (int bj = 0; bj < 2; ++bj)
#pragma unroll
                    for (int n = 0; n < 2; ++n) *(f32x4*)(xp + (size_t)m * 16 * 1024 + bj * 128 + n * 16) = xv[m][bj][n] + g4[bj][n] * acc[ai][bj][m][n];
        }
    }
};
struct EpiFfnIn {
    static constexpr bool PERM = true;
    bf16_t* ACT;
    __device__ __forceinline__ void operator()(const Acc& acc, const Unit& u, int wr, int wc, int fr, int fq) const {
        { const int ln = fresh_lane(); fr = ln & 15; fq = ln >> 4; }
#pragma unroll
        for (int ai = 0; ai < 2; ++ai)
#pragma unroll
            for (int m = 0; m < 4; ++m) {
                const int row = u.pm * 256 + ai * 128 + wr * 64 + m * 16 + fr; const int c0 = u.pn * 128 + wc * 32 + fq * 8;
                f32x4 a0, a1;
#pragma unroll
                for (int i = 0; i < 4; ++i) { a0[i] = siluf_(acc[ai][0][m][0][i]) * acc[ai][1][m][0][i]; a1[i] = siluf_(acc[ai][0][m][1][i]) * acc[ai][1][m][1][i]; }
                *(u32x4*)(ACT + (size_t)row * DFF + c0) = pack8(a0, a1);
            }
    }
};
struct EpiS {
    static constexpr bool PERM = false;
    float* S;
    __device__ __forceinline__ void operator()(const Acc& acc, const Unit& u, int wr, int wc, int fr, int fq) const {
        { const int ln = fresh_lane(); fr = ln & 15; fq = ln >> 4; }
#pragma unroll
        for (int ai = 0; ai < 2; ++ai)
#pragma unroll
            for (int m = 0; m < 4; ++m) {
                const size_t row = (size_t)u.pm * 256 + ai * 128 + wr * 64 + m * 16 + fr;
#pragma unroll
                for (int bj = 0; bj < 2; ++bj)
#pragma unroll
                    for (int n = 0; n < 2; ++n) *(f32x4*)(S + row * 256 + bj * 128 + wc * 32 + n * 16 + fq * 4) = acc[ai][bj][m][n];
            }
    }
};
struct EpiY {
    static constexpr bool PERM = true;
    const bf16_t* SSMA; bf16_t* Z; const float* dskip;
    __device__ __forceinline__ void operator()(const Acc& acc, const Unit& u, int wr, int wc, int fr, int fq) const {
        { const int ln = fresh_lane(); fr = ln & 15; fq = ln >> 4; }
        const int g = u.pm >> 3;
        const f32x4 d0 = *(const f32x4*)(dskip + g * 16 + 8 * (fq & 1)), d1 = *(const f32x4*)(dskip + g * 16 + 8 * (fq & 1) + 4);
#pragma unroll
        for (int ai = 0; ai < 2; ++ai) {
            const int rl0 = ai * 128 + wr * 64 + fr; const size_t arow0 = (size_t)u.pm * 256 + rl0; const int cr0 = (u.pm & 7) * 256 + rl0;
            const int nc0 = wc * 32 + fq * 8;
            u32x4 uw[4][2];
#pragma unroll
            for (int m = 0; m < 4; ++m)
#pragma unroll
                for (int bj = 0; bj < 2; ++bj) uw[m][bj] = *(const u32x4*)(SSMA + (arow0 + m * 16) * 512 + bj * 128 + nc0);
#pragma unroll
            for (int m = 0; m < 4; ++m)
#pragma unroll
                for (int bj = 0; bj < 2; ++bj) asm volatile("" : "+v"(uw[m][bj]));
#pragma unroll
            for (int m = 0; m < 4; ++m)
#pragma unroll
                for (int bj = 0; bj < 2; ++bj) {
                    const int tau = (bj * 128 + nc0) >> 4; const u32x4 w = uw[m][bj];
                    f32x4 y0 = acc[ai][bj][m][0], y1 = acc[ai][bj][m][1];
                    y0[0] += d0[0] * bflo(w.x); y0[1] += d0[1] * bfhi(w.x); y0[2] += d0[2] * bflo(w.y); y0[3] += d0[3] * bfhi(w.y);
                    y1[0] += d1[0] * bflo(w.z); y1[1] += d1[1] * bfhi(w.z); y1[2] += d1[2] * bflo(w.w); y1[3] += d1[3] * bfhi(w.w);
#pragma unroll
                    for (int i = 0; i < 4; ++i) { y0[i] = gelu_tanh(y0[i]); y1[i] = gelu_tanh(y1[i]); }
                    *(u32x4*)(Z + ((size_t)(cr0 + m * 16) * 16 + tau) * 512 + g * 16 + 8 * (fq & 1)) = pack8(y0, y1);
                }
        }
    }
};
struct EpiMerge {
    static constexpr bool PERM = true;
    bf16_t* GA; bf16_t* GS; const float* bglu;
    __device__ __forceinline__ void operator()(const Acc& acc, const Unit& u, int wr, int wc, int fr, int fq) const {
        { const int ln = fresh_lane(); fr = ln & 15; fq = ln >> 4; }
        if (u.aux == 0) {
            const int yc0 = u.pn * 128 + wc * 32 + fq * 8;
            const f32x4 bl0 = *(const f32x4*)(bglu + yc0), bl1 = *(const f32x4*)(bglu + yc0 + 4), bg0 = *(const f32x4*)(bglu + 1024 + yc0), bg1 = *(const f32x4*)(bglu + 1024 + yc0 + 4);
            bf16_t* gp0 = GS + (size_t)(u.pm * 256 + wr * 64 + fr) * 1024 + yc0;
            u32x4 gw[2][4];
#pragma unroll
            for (int ai = 0; ai < 2; ++ai)
#pragma unroll
                for (int m = 0; m < 4; ++m) gw[ai][m] = *(const u32x4*)(gp0 + (size_t)(ai * 128 + m * 16) * 1024);
#pragma unroll
            for (int ai = 0; ai < 2; ++ai)
#pragma unroll
                for (int m = 0; m < 4; ++m) asm volatile("" : "+v"(gw[ai][m]));
#pragma unroll
            for (int ai = 0; ai < 2; ++ai)
#pragma unroll
                for (int m = 0; m < 4; ++m) {
                    const u32x4 g = gw[ai][m];
                    f32x4 s0, s1;
                    s0[0] = bflo(g.x); s0[1] = bfhi(g.x); s0[2] = bflo(g.y); s0[3] = bfhi(g.y); s1[0] = bflo(g.z); s1[1] = bfhi(g.z); s1[2] = bflo(g.w); s1[3] = bfhi(g.w);
                    f32x4 y0, y1;
#pragma unroll
                    for (int i = 0; i < 4; ++i) { y0[i] = s0[i] * (acc[ai][0][m][0][i] + bl0[i]) * sigmoidf_(acc[ai][1][m][0][i] + bg0[i]); y1[i] = s1[i] * (acc[ai][0][m][1][i] + bl1[i]) * sigmoidf_(acc[ai][1][m][1][i] + bg1[i]); }
                    *(u32x4*)(gp0 + (size_t)(ai * 128 + m * 16) * 1024) = pack8(y0, y1);
                }
        } else {
#pragma unroll
            for (int ai = 0; ai < 2; ++ai) {
                const size_t roff = (size_t)(u.pm * 256 + ai * 128 + wr * 64 + fr) * 1024 + u.pn * 256 + wc * 32 + fq * 8;
                u32x4 gw[4][2], tw[4][2];
#pragma unroll
                for (int m = 0; m < 4; ++m)
#pragma unroll
                    for (int bj = 0; bj < 2; ++bj) { gw[m][bj] = *(const u32x4*)(GA + roff + (size_t)m * 16 * 1024 + bj * 128); tw[m][bj] = *(const u32x4*)(GS + roff + (size_t)m * 16 * 1024 + bj * 128); }
#pragma unroll
                for (int m = 0; m < 4; ++m)
#pragma unroll
                    for (int bj = 0; bj < 2; ++bj) asm volatile("" : "+v"(gw[m][bj]), "+v"(tw[m][bj]));
#pragma unroll
                for (int m = 0; m < 4; ++m)
#pragma unroll
                    for (int bj = 0; bj < 2; ++bj) {
                        const u32x4 g = gw[m][bj], t = tw[m][bj];
                        const f32x4 a0 = acc[ai][bj][m][0], a1 = acc[ai][bj][m][1];
                        f32x4 o0, o1;
                        o0[0] = bflo(g.x) * a0[0] + bflo(t.x); o0[1] = bfhi(g.x) * a0[1] + bfhi(t.x); o0[2] = bflo(g.y) * a0[2] + bflo(t.y); o0[3] = bfhi(g.y) * a0[3] + bfhi(t.y);
                        o1[0] = bflo(g.z) * a1[0] + bflo(t.z); o1[1] = bfhi(g.z) * a1[1] + bfhi(t.z); o1[2] = bflo(g.w) * a1[2] + bflo(t.w); o1[3] = bfhi(g.w) * a1[3] + bfhi(t.w);
                        *(u32x4*)(GA + roff + (size_t)m * 16 * 1024 + bj * 128) = pack8(o0, o1);
                    }
            }
        }
    }
};

namespace att {
constexpr int QBLK = 32, KVBLK = 64, LDX = 512;
constexpr int NSLOT = 4, SHM_V = 16384, SHM_K = 8192, OFF_K = NSLOT * SHM_V, OFF_WS = NSLOT * (SHM_V + SHM_K);
constexpr float SCALE = 0.125f, THR = 8.f;
#define KSWZ(row, colB) ((row) * 128 + ((colB) ^ ((((row) >> 1) & 7) << 4)))
#define SBAR() __builtin_amdgcn_sched_barrier(0)
__device__ __forceinline__ int crow(int r, int hi) { return (r & 3) + 8 * (r >> 2) + 4 * hi; }
__device__ __forceinline__ void partialSM(f32x16& p0, f32x16& p1, float& mhat, f32x16& negm, float& alpha, const bool first) {
    constexpr float THRL = THR * 1.4426950408889634f;
    float pmax = fmaxf(p0[0], p0[1]), m1 = fmaxf(p0[2], p0[3]), m2 = fmaxf(p1[0], p1[1]), m3 = fmaxf(p1[2], p1[3]);
#pragma unroll
    for (int r = 4; r < 16; r += 4) { pmax = fmaxf(fmaxf(pmax, p0[r]), p0[r + 1]); m1 = fmaxf(fmaxf(m1, p0[r + 2]), p0[r + 3]); m2 = fmaxf(fmaxf(m2, p1[r]), p1[r + 1]); m3 = fmaxf(fmaxf(m3, p1[r + 2]), p1[r + 3]); }
    pmax = fmaxf(fmaxf(pmax, m1), fmaxf(m2, m3));
    { auto rr = __builtin_amdgcn_permlane32_swap(__float_as_uint(pmax), __float_as_uint(pmax), false, false);
      pmax = fmaxf(__uint_as_float(rr[0]), __uint_as_float(rr[1])); }
    if (__builtin_expect(!first && __all(pmax <= THRL), 1)) { alpha = 1.f; }
    else { const float dl = first ? pmax : fmaxf(pmax, 0.f); mhat += dl; alpha = first ? 0.f : __builtin_amdgcn_exp2f(-dl);
#pragma unroll
        for (int r = 0; r < 16; ++r) { p0[r] -= dl; p1[r] -= dl; }
#pragma unroll
        for (int r = 0; r < 16; ++r) negm[r] = -mhat; }
#pragma unroll
    for (int r = 0; r < 16; ++r) p0[r] = __builtin_amdgcn_exp2f(p0[r]);
}
__device__ __forceinline__ void finishSM(f32x16& p0, f32x16& p1, float alpha, float& l_reg, bf16x8& pa0, bf16x8& pa1, bf16x8& pa2, bf16x8& pa3) {
#pragma unroll
    for (int r = 0; r < 16; ++r) p1[r] = __builtin_amdgcn_exp2f(p1[r]);
    float ps, s1, s2, s3;
    ps = p0[0] + p0[1]; s1 = p0[2] + p0[3]; s2 = p1[0] + p1[1]; s3 = p1[2] + p1[3];
#pragma unroll
    for (int r = 4; r < 16; r += 2) { ps += p0[r]; s1 += p0[r + 1]; s2 += p1[r]; s3 += p1[r + 1]; }
    ps = (ps + s1) + (s2 + s3);
    { auto rr = __builtin_amdgcn_permlane32_swap(__float_as_uint(ps), __float_as_uint(ps), false, false);
      ps = __uint_as_float(rr[0]) + __uint_as_float(rr[1]); }
    l_reg = l_reg * alpha + ps;
#define PK4(P, BASE, OUT) do { unsigned a0 = cvt_pk_bf16(P[BASE + 0], P[BASE + 1]), a1 = cvt_pk_bf16(P[BASE + 2], P[BASE + 3]);   \
    unsigned b0 = cvt_pk_bf16(P[BASE + 4], P[BASE + 5]), b1 = cvt_pk_bf16(P[BASE + 6], P[BASE + 7]);                              \
    auto r0 = __builtin_amdgcn_permlane32_swap(a0, b0, false, false); auto r1 = __builtin_amdgcn_permlane32_swap(a1, b1, false, false); \
    u32x4 w = {r0[0], r1[0], r0[1], r1[1]}; OUT = __builtin_bit_cast(bf16x8, w); } while (0)
    PK4(p0, 0, pa0); PK4(p0, 8, pa1); PK4(p1, 0, pa2); PK4(p1, 8, pa3);
#undef PK4
}
__device__ __forceinline__ void qkt(f32x16& p0, f32x16& p1, const LAS char* Ks, const bf16x8* qr, const f32x16& negm, int r32, int hi) {
#pragma unroll
    for (int d0 = 0; d0 < 4; ++d0) { const int cb = (d0 * 16 + hi * 8) * 2;
        const bf16x8 b0 = *(const LAS bf16x8*)(Ks + KSWZ(r32, cb));
        const bf16x8 b1 = *(const LAS bf16x8*)(Ks + KSWZ(32 + r32, cb));
        if (d0 == 0) { p0 = __builtin_amdgcn_mfma_f32_32x32x16_bf16(b0, qr[0], negm, 0, 0, 0); p1 = __builtin_amdgcn_mfma_f32_32x32x16_bf16(b1, qr[0], negm, 0, 0, 0); }
        else { p0 = __builtin_amdgcn_mfma_f32_32x32x16_bf16(b0, qr[d0], p0, 0, 0, 0); p1 = __builtin_amdgcn_mfma_f32_32x32x16_bf16(b1, qr[d0], p1, 0, 0, 0); } }
}
__device__ __forceinline__ int v_st(int k, int c) { const int kk = (k & ~0xC) | ((k & 4) << 1) | ((k & 8) >> 1); return ((kk >> 3) * 4 + (c >> 5)) * 512 + ((kk & 7) * 32 + (c & 31)) * 2; }
__device__ __forceinline__ int v_rd_base(int lane) { return ((lane & 3) << 3) | (((lane >> 2) & 3) << 6) | (((lane >> 4) & 1) << 5) | (((lane >> 5) & 1) << 8); }
constexpr int v_rd_off(int d0, int ks, int half) { return d0 * 512 + ks * 4096 + half * 2048; }
template <int OFF> __device__ __forceinline__ s16x4 tr_read(int vb) {
    s16x4 r; asm volatile("ds_read_b64_tr_b16 %0, %1 offset:%2" : "=&v"(r) : "v"(vb), "i"(OFF) : "memory"); return r;
}
template <int D0> __device__ __forceinline__ void pv_one(f32x16& od, int vb, bf16x8 pa0, bf16x8 pa1, bf16x8 pa2, bf16x8 pa3) {
    const s16x4 l0 = tr_read<v_rd_off(D0, 0, 0)>(vb), h0 = tr_read<v_rd_off(D0, 0, 1)>(vb), l1 = tr_read<v_rd_off(D0, 1, 0)>(vb), h1 = tr_read<v_rd_off(D0, 1, 1)>(vb);
    const s16x4 l2 = tr_read<v_rd_off(D0, 2, 0)>(vb), h2 = tr_read<v_rd_off(D0, 2, 1)>(vb), l3 = tr_read<v_rd_off(D0, 3, 0)>(vb), h3 = tr_read<v_rd_off(D0, 3, 1)>(vb);
    asm volatile("s_waitcnt lgkmcnt(0)" ::: "memory"); SBAR();
#define PK(L, H) (bf16x8){L[0], L[1], L[2], L[3], H[0], H[1], H[2], H[3]}
    od = __builtin_amdgcn_mfma_f32_32x32x16_bf16(pa0, PK(l0, h0), od, 0, 0, 0);
    od = __builtin_amdgcn_mfma_f32_32x32x16_bf16(pa1, PK(l1, h1), od, 0, 0, 0);
    od = __builtin_amdgcn_mfma_f32_32x32x16_bf16(pa2, PK(l2, h2), od, 0, 0, 0);
    od = __builtin_amdgcn_mfma_f32_32x32x16_bf16(pa3, PK(l3, h3), od, 0, 0, 0);
#undef PK
}
__device__ __forceinline__ void pv_d0(f32x16* o, int vb, bf16x8 pa0, bf16x8 pa1, bf16x8 pa2, bf16x8 pa3) {
    pv_one<0>(o[0], vb, pa0, pa1, pa2, pa3); pv_one<1>(o[1], vb, pa0, pa1, pa2, pa3); pv_one<2>(o[2], vb, pa0, pa1, pa2, pa3); pv_one<3>(o[3], vb, pa0, pa1, pa2, pa3);
}
__device__ __forceinline__ void attn_pass(const bf16_t* __restrict__ Qb, const bf16_t* __restrict__ Kh, const bf16_t* __restrict__ Vh, int seq, LAS char* lds, const int wid, f32x16 (&o)[4], float (&rli)[16]) {
    const int lane = fresh_lane(), tid = wid * 64 + lane, r32 = lane & 31, hi = lane >> 5;
    LAS char* V_lds = lds; LAS char* K_lds = lds + OFF_K;
    LAS float* ws = (LAS float*)(lds + OFF_WS) + wid * 64; LAS float* li_l = ws; LAS float* al_l = ws + 32;
    float mhat = 0.f, l_reg = 0; f32x16 negm = f32x16{};
#pragma unroll
    for (int d = 0; d < 4; ++d) o[d] = f32x16{};
    bf16x8 qr[4];
    const bf16_t* Qw = Qb + (size_t)(wid * QBLK + r32) * LDX + hi * 8;
#pragma unroll
    for (int d0 = 0; d0 < 4; ++d0) qr[d0] = *(const bf16x8*)(Qw + d0 * 16);
    const int sr = tid >> 4, sc = (tid & 15) * 8, vst0 = v_st(sr, sc), vst1 = v_st(32 + sr, sc);
    const int kr = tid >> 3, kc = (tid & 7) * 8, kst = KSWZ(kr, kc * 2);
    const int vb0 = (int)(unsigned)(uintptr_t)V_lds + v_rd_base(lane);
    struct { bf16x8 vs0, vs1, ks0; } sr_[2];
#define SLOAD(i, k0) do { sr_[i].vs0 = *(const bf16x8*)(&Vh[(size_t)((k0) + sr) * LDX + sc]); sr_[i].vs1 = *(const bf16x8*)(&Vh[(size_t)((k0) + 32 + sr) * LDX + sc]); \
    sr_[i].ks0 = *(const bf16x8*)(&Kh[(size_t)((k0) + kr) * LDX + kc]); } while (0)
#define SWRITE(b, i) do { *(LAS bf16x8*)(V_lds + (b) * SHM_V + vst0) = sr_[i].vs0; *(LAS bf16x8*)(V_lds + (b) * SHM_V + vst1) = sr_[i].vs1; \
    *(LAS bf16x8*)(K_lds + (b) * SHM_K + kst) = sr_[i].ks0; } while (0)
#define SWAIT() asm volatile("s_waitcnt vmcnt(3)" ::: "memory")
#define RESC(a) do { if (__any((a) < 1.f)) { if (hi == 0) al_l[r32] = (a); asm volatile("s_waitcnt lgkmcnt(0)" ::: "memory"); \
    _Pragma("unroll") for (int d = 0; d < 4; ++d) _Pragma("unroll") for (int r = 0; r < 16; ++r) o[d][r] *= al_l[crow(r, hi)]; } } while (0)
    f32x16 pA0, pA1; float alA; bf16x8 pa0, pa1, pa2, pa3; const int NT = seq / KVBLK;
#define WBAR() asm volatile("s_waitcnt lgkmcnt(0)\n\ts_barrier" ::: "memory")
    const bool lag = wid >= 4;
    SLOAD(0, 0); asm volatile("s_waitcnt vmcnt(0)" ::: "memory"); SWRITE(0, 0);
    SLOAD(1, KVBLK); SLOAD(0, 2 * KVBLK);
    __syncthreads();
    qkt(pA0, pA1, K_lds, qr, negm, r32, hi);
    partialSM(pA0, pA1, mhat, negm, alA, true); finishSM(pA0, pA1, alA, l_reg, pa0, pa1, pa2, pa3);
    SWAIT(); SWRITE(1, 1);
    SLOAD(1, 3 * KVBLK);
    SWAIT(); SWRITE(2, 0);
    __syncthreads();
    if (lag) WBAR();
    for (int j = 1; j + 1 < NT; j += 2) {
        SBAR(); __builtin_amdgcn_s_setprio(1); qkt(pA0, pA1, K_lds + (j & 3) * SHM_K, qr, negm, r32, hi); pv_d0(o, vb0 + ((j - 1) & 3) * SHM_V, pa0, pa1, pa2, pa3); __builtin_amdgcn_s_setprio(0); SBAR();
        WBAR();
        SWRITE((j + 2) & 3, 1);
        if (j + 3 < NT) SLOAD(0, (j + 3) * KVBLK);
        partialSM(pA0, pA1, mhat, negm, alA, false); RESC(alA); finishSM(pA0, pA1, alA, l_reg, pa0, pa1, pa2, pa3);
        WBAR();
        SBAR(); __builtin_amdgcn_s_setprio(1); qkt(pA0, pA1, K_lds + ((j + 1) & 3) * SHM_K, qr, negm, r32, hi); pv_d0(o, vb0 + (j & 3) * SHM_V, pa0, pa1, pa2, pa3); __builtin_amdgcn_s_setprio(0); SBAR();
        WBAR();
        if (j + 3 < NT) SWRITE((j + 3) & 3, 0);
        if (j + 4 < NT) SLOAD(1, (j + 4) * KVBLK);
        partialSM(pA0, pA1, mhat, negm, alA, false); RESC(alA); finishSM(pA0, pA1, alA, l_reg, pa0, pa1, pa2, pa3);
        WBAR();
    }
    SBAR(); __builtin_amdgcn_s_setprio(1); qkt(pA0, pA1, K_lds + ((NT - 1) & 3) * SHM_K, qr, negm, r32, hi); pv_d0(o, vb0 + ((NT - 2) & 3) * SHM_V, pa0, pa1, pa2, pa3); __builtin_amdgcn_s_setprio(0); SBAR();
    WBAR();
    partialSM(pA0, pA1, mhat, negm, alA, false); RESC(alA); finishSM(pA0, pA1, alA, l_reg, pa0, pa1, pa2, pa3);
    WBAR();
    SBAR(); pv_d0(o, vb0 + ((NT - 1) & 3) * SHM_V, pa0, pa1, pa2, pa3);
    if (!lag) WBAR();
#undef WBAR
    if (hi == 0) li_l[r32] = l_reg; asm volatile("s_waitcnt lgkmcnt(0)" ::: "memory");
#pragma unroll
    for (int r = 0; r < 16; ++r) rli[r] = __builtin_amdgcn_rcpf(li_l[crow(r, hi)]);
    asm volatile("s_waitcnt vmcnt(0) lgkmcnt(0)" ::: "memory");
    __syncthreads();
#undef SLOAD
#undef SWRITE
#undef SWAIT
#undef RESC
}
}

#define WSP(T, off) ((T*)(fresh_ptr(ws) + (off)))
#define MOD WSP(float, WS_MOD)
#define ROPE WSP(float, WS_ROPE)
#define A16 WSP(float, WS_A16)
#define WIN WSP(bf16_t, WS_WIN)
#define WATT WSP(bf16_t, WS_WATT)
#define WGLU WSP(bf16_t, WS_WGLU)
#define WO WSP(bf16_t, WS_WO)
#define WFI WSP(bf16_t, WS_WFI)
#define WFO WSP(bf16_t, WS_WFO)
#define BTS WSP(bf16_t, WS_BTS)
#define BTY WSP(bf16_t, WS_BTY)
#define Hb WSP(bf16_t, WS_H)
#define Sb WSP(float, WS_H)
#define Zb WSP(bf16_t, WS_H)
#define Qb WSP(bf16_t, WS_Q)
#define Kb WSP(bf16_t, WS_K)
#define Vb WSP(bf16_t, WS_V)
#define SSMA WSP(bf16_t, WS_SSMA)
#define GA WSP(bf16_t, WS_GA)
#define GS WSP(bf16_t, WS_GS)
#define ACT WSP(bf16_t, WS_ACT)
#define STASH (WSP(float, WS_STASH) + (size_t)bx * 65536)

__device__ __forceinline__ int dstrow(int mode, int n) {
    if (mode == 1) { if (n < 1024) { const int d = n & 63; return (n & ~63) + ((d & 31) << 1) + (d >> 5); } return n; }
    if (mode == 2) { const int c = n < 1024 ? n : n - 1024; return 256 * (c >> 7) + (n < 1024 ? 0 : 128) + (c & 127); }
    if (mode == 3) { const int c = n < DFF ? n : n - DFF; return 256 * (c >> 7) + (n < DFF ? 0 : 128) + (c & 127); }
    return n;
}
__device__ __forceinline__ void transpose_item(const float* __restrict__ W, int K, int N, bf16_t* __restrict__ WT, int mode, LAS float* scr, int item, int lane) {
    const int nblk = N / 32, kb = item / nblk, nb = item % nblk, k0 = 64 * kb, n0 = 32 * nb;
#pragma unroll 8
    for (int i = 0; i < 32; ++i) { const int kk = 2 * i + (lane >> 5); scr[kk * 33 + (lane & 31)] = W[(size_t)(k0 + kk) * N + n0 + (lane & 31)]; }
    asm volatile("s_waitcnt lgkmcnt(0)" ::: "memory");
    const int c = lane & 7;
#pragma unroll
    for (int j = 0; j < 4; ++j) { const int n = (lane >> 3) + 8 * j; const LAS float* s = scr + (8 * c) * 33 + n;
        u32x4 o; o.x = cvt_pk_bf16(s[0 * 33], s[1 * 33]); o.y = cvt_pk_bf16(s[2 * 33], s[3 * 33]); o.z = cvt_pk_bf16(s[4 * 33], s[5 * 33]); o.w = cvt_pk_bf16(s[6 * 33], s[7 * 33]);
        *(u32x4*)(WT + (size_t)dstrow(mode, n0 + n) * K + k0 + 8 * c) = o; }
    asm volatile("s_waitcnt lgkmcnt(0)" ::: "memory");
}

__device__ __forceinline__ void convert_job(const Args& a, unsigned char* ws, int l, int mask, LAS unsigned char* lds, int wave, int cw, int ncw) {
    const int lane = fresh_lane();
    LAS float* scr = (LAS float*)(lds + wave * 16384);
    constexpr int I_IN = 16 * 128, I_AT = 8 * 32, I_GL = 8 * 64, I_WO = 16 * 32, I_FI = 16 * 176, I_FO = 44 * 32;
    if (mask & 1) for (int r = cw; r < I_IN; r += ncw) transpose_item(a.in[7] + (size_t)l * 1024 * 4096, 1024, 4096, WIN, 1, scr, r, lane);
    if (mask & 2) for (int it = cw; it < I_AT + I_GL + I_WO; it += ncw) { int r = it;
        if (r < I_AT) { transpose_item(a.in[13] + (size_t)l * 512 * 1024, 512, 1024, WATT, 0, scr, r, lane); continue; } r -= I_AT;
        if (r < I_GL) { transpose_item(a.in[22] + (size_t)l * 512 * 2048, 512, 2048, WGLU, 2, scr, r, lane); continue; } r -= I_GL;
        transpose_item(a.in[24] + (size_t)l * 1024 * 1024, 1024, 1024, WO, 0, scr, r, lane); }
    if (mask & 4) for (int it = cw; it < I_FI + I_FO; it += ncw) { int r = it;
        if (r < I_FI) { transpose_item(a.in[26] + (size_t)l * 1024 * 5632, 1024, 5632, WFI, 3, scr, r, lane); continue; } r -= I_FI;
        transpose_item(a.in[27] + (size_t)l * 2816 * 1024, 2816, 1024, WFO, 0, scr, r, lane); }
}

__device__ __forceinline__ void ssm_gen(const Args& a, int l, int g, LAS float* L, bf16_t* bts_, bf16_t* bty_, float* a16_, int wave) {
    const int tid = fresh_tid(wave);
    LAS float* Ap = L; LAS float* Bb = L + 4352; LAS float* Cc = Bb + 4096; LAS float* Kt = Cc + 4096;
    const float* a_re = a.in[14]; const float* a_im = a.in[15]; const float* log_dt = a.in[16];
    const float* b_re = a.in[17]; const float* b_im = a.in[18]; const float* c_re = a.in[19]; const float* c_im = a.in[20];
    if (tid < 128) {
        const int dir = tid >> 6, p = tid & 63; const int gi = (l * 2 + dir) * 32 + g;
        const float dt = expf(log_dt[gi]), ar = a_re[gi * 64 + p], ai = a_im[gi * 64 + p];
        const float mag = expf(dt * ar), abr = mag * cosf(dt * ai), abi = mag * sinf(dt * ai);
        const float nr = abr - 1.0f, ni = abi, den = ar * ar + ai * ai;
        const float fr = (nr * ar + ni * ai) / den, fi = (ni * ar - nr * ai) / den;
        float pr = 1.f, pi = 0.f; asm volatile("" : "+v"(pr), "+v"(pi));
        for (int j = 0; j <= 16; ++j) { Ap[((dir * 17 + j) * 64 + p) * 2] = pr; Ap[((dir * 17 + j) * 64 + p) * 2 + 1] = pi; const float t = pr * abr - pi * abi; pi = pr * abi + pi * abr; pr = t; }
        a16_[((g * 2 + dir) * 64 + p) * 2] = Ap[((dir * 17 + 16) * 64 + p) * 2]; a16_[((g * 2 + dir) * 64 + p) * 2 + 1] = Ap[((dir * 17 + 16) * 64 + p) * 2 + 1];
        for (int c = 0; c < 16; ++c) { const float br = b_re[((size_t)gi * 64 + p) * 16 + c], bi = b_im[((size_t)gi * 64 + p) * 16 + c];
            Bb[((dir * 64 + p) * 16 + c) * 2] = fr * br - fi * bi; Bb[((dir * 64 + p) * 16 + c) * 2 + 1] = fr * bi + fi * br; }
    }
    for (int i = tid; i < 2048; i += NTHREADS) { const int dir = i >> 10, cp = i & 1023; const int gi = (l * 2 + dir) * 32 + g;
        Cc[i * 2] = c_re[(size_t)gi * 1024 + cp]; Cc[i * 2 + 1] = c_im[(size_t)gi * 1024 + cp]; }
    __syncthreads();
    for (int idx = tid; idx < 8192; idx += NTHREADS) {
        const int cp = idx & 15, c = (idx >> 4) & 15, j = (idx >> 8) & 15, dir = idx >> 12; float s = 0.f;
        for (int p = 0; p < 64; ++p) {
            const float cr = Cc[((dir * 16 + c) * 64 + p) * 2], ci = Cc[((dir * 16 + c) * 64 + p) * 2 + 1];
            const float pr = Ap[((dir * 17 + j) * 64 + p) * 2], pi = Ap[((dir * 17 + j) * 64 + p) * 2 + 1];
            const float br = Bb[((dir * 64 + p) * 16 + cp) * 2], bi = Bb[((dir * 64 + p) * 16 + cp) * 2 + 1];
            const float car = cr * pr - ci * pi, cai = cr * pi + ci * pr;
            s += car * br - cai * bi;
        }
        Kt[idx] = s;
    }
    __syncthreads();
    for (int ch = tid; ch < 256 * 32; ch += NTHREADS) {
        const int n = ch >> 5, k0 = (ch & 31) * 8; const int dir = n >> 7, ri = (n >> 6) & 1, p = n & 63; float v[8];
#pragma unroll
        for (int e = 0; e < 8; ++e) { const int k = k0 + e, sg = k >> 4, c = k & 15, ex = dir ? sg : 15 - sg;
            const float pr = Ap[((dir * 17 + ex) * 64 + p) * 2], pi = Ap[((dir * 17 + ex) * 64 + p) * 2 + 1], br = Bb[((dir * 64 + p) * 16 + c) * 2], bi = Bb[((dir * 64 + p) * 16 + c) * 2 + 1];
            v[e] = ri ? (pr * bi + pi * br) : (pr * br - pi * bi); }
        u32x4 w; w.x = cvt_pk_bf16(v[0], v[1]); w.y = cvt_pk_bf16(v[2], v[3]); w.z = cvt_pk_bf16(v[4], v[5]); w.w = cvt_pk_bf16(v[6], v[7]);
        *(u32x4*)(bts_ + ((size_t)g * 256 + n) * 256 + k0) = w;
    }
    for (int ch = tid; ch < 256 * 64; ch += NTHREADS) {
        const int n = ch >> 6, k0 = (ch & 63) * 8; const int tau = n >> 4, c = n & 15; float v[8];
#pragma unroll
        for (int e = 0; e < 8; ++e) { const int k = k0 + e; float x;
            if (k < 256) { const int sg = k >> 4, cp = k & 15; x = 0.f;
                if (sg <= tau) x += Kt[((0 * 16 + (tau - sg)) * 16 + c) * 16 + cp];
                if (sg >= tau) x += Kt[((1 * 16 + (sg - tau)) * 16 + c) * 16 + cp];
            } else { const int kk = k - 256, dir = kk >> 7, ri = (kk >> 6) & 1, p = kk & 63, ex = dir ? 16 - tau : tau + 1;
                const float cr = Cc[((dir * 16 + c) * 64 + p) * 2], ci = Cc[((dir * 16 + c) * 64 + p) * 2 + 1], pr = Ap[((dir * 17 + ex) * 64 + p) * 2], pi = Ap[((dir * 17 + ex) * 64 + p) * 2 + 1];
                x = ri ? -(cr * pi + ci * pr) : (cr * pr - ci * pi); }
            v[e] = x; }
        u32x4 w; w.x = cvt_pk_bf16(v[0], v[1]); w.y = cvt_pk_bf16(v[2], v[3]); w.z = cvt_pk_bf16(v[4], v[5]); w.w = cvt_pk_bf16(v[6], v[7]);
        *(u32x4*)(bty_ + ((size_t)g * 256 + n) * 512 + k0) = w;
    }
    __syncthreads();
}

__device__ __forceinline__ void norm_rows(const float* __restrict__ x, bf16_t* __restrict__ H, const float* __restrict__ gam, const float* __restrict__ modl  ,
                                          int sh_off, int sc_off, int Lshift, int gw, int NGW, int lane_in) {
    const int lane = fresh_lane(); (void)lane_in;
    const int nb = MG >> Lshift, wpb = NGW / nb;
    if (wpb * nb == NGW && ((1 << Lshift) % (4 * wpb)) == 0) {
        const int b = gw / wpb, r0 = gw % wpb, L = 1 << Lshift;
        const float* mb = modl + (size_t)b * 6144;
        f32x4 gm[4], sh[4];
#pragma unroll
        for (int j = 0; j < 4; ++j) { const f32x4 g4 = *(const f32x4*)(gam + 4 * lane + 256 * j), sc = *(const f32x4*)(mb + sc_off + 4 * lane + 256 * j);
            gm[j] = g4 * (sc + 1.0f); sh[j] = *(const f32x4*)(mb + sh_off + 4 * lane + 256 * j); }
        const float* xb = x + (size_t)b * L * D; bf16_t* hb = H + (size_t)b * L * D;
        for (int r = r0; r < L; r += 4 * wpb) {
            f32x4 v[4][4]; float s[4];
#pragma unroll
            for (int q = 0; q < 4; ++q) { const f32x4* xr = (const f32x4*)(xb + (size_t)(r + q * wpb) * D) + lane;
#pragma unroll
                for (int j = 0; j < 4; ++j) v[q][j] = __builtin_nontemporal_load(&xr[64 * j]); }
#pragma unroll
            for (int q = 0; q < 4; ++q) { float t = 0.f;
#pragma unroll
                for (int j = 0; j < 4; ++j) t += (v[q][j].x * v[q][j].x + v[q][j].y * v[q][j].y) + (v[q][j].z * v[q][j].z + v[q][j].w * v[q][j].w);
                s[q] = rsqrtf(wave_sum(t) * (1.f / D) + EPS); }
#pragma unroll
            for (int q = 0; q < 4; ++q) {
                u32x2* o = (u32x2*)(hb + (size_t)(r + q * wpb) * D) + lane;
#pragma unroll
                for (int j = 0; j < 4; ++j) { const f32x4 h = v[q][j] * s[q] * gm[j] + sh[j];
                    u32x2 w; w.x = cvt_pk_bf16(h[0], h[1]); w.y = cvt_pk_bf16(h[2], h[3]); o[64 * j] = w; }
            }
        }
        return;
    }
    f32x4 gv[4];
#pragma unroll
    for (int j = 0; j < 4; ++j) gv[j] = *(const f32x4*)(gam + 4 * lane + 256 * j);
    for (int row = gw; row < MG; row += NGW) {
        const f32x4* xr = (const f32x4*)(x + (size_t)row * D) + lane;
        f32x4 v[4]; float s = 0.f;
#pragma unroll
        for (int j = 0; j < 4; ++j) { v[j] = xr[64 * j]; s += (v[j].x * v[j].x + v[j].y * v[j].y) + (v[j].z * v[j].z + v[j].w * v[j].w); }
        const float r = rsqrtf(wave_sum(s) * (1.f / D) + EPS);
        const float* mb = modl + (size_t)(row >> Lshift) * 6144;
        u32x2* o = (u32x2*)(H + (size_t)row * D) + lane;
#pragma unroll
        for (int j = 0; j < 4; ++j) {
            const f32x4 sc = *(const f32x4*)(mb + sc_off + 4 * lane + 256 * j), sh = *(const f32x4*)(mb + sh_off + 4 * lane + 256 * j);
            const f32x4 h = v[j] * r * gv[j] * (sc + 1.0f) + sh;
            u32x2 w; w.x = cvt_pk_bf16(h[0], h[1]); w.y = cvt_pk_bf16(h[2], h[3]); o[64 * j] = w;
        }
    }
}

#define XB_TMO      128
#define XB_XCNT(j)  (256  + 64 * (j))
#define XB_XSUB(j)  (1280 + 64 * (j))
#define XB_XGEN(j)  (2304 + 64 * (j))
#define XB_TOP      3328
#define XB_TOPGEN   3392
#define XCD_BAR_WORDS 3456
#define XB_SPIN_CAP (1u << 18)
__device__ __forceinline__ unsigned xb_ld(unsigned* p)              { return __hip_atomic_load(p, __ATOMIC_RELAXED, __HIP_MEMORY_SCOPE_AGENT); }
__device__ __forceinline__ unsigned xb_add(unsigned* p, unsigned v) { return __hip_atomic_fetch_add(p, v, __ATOMIC_RELAXED, __HIP_MEMORY_SCOPE_AGENT); }
__device__ __forceinline__ unsigned xb_xcc_id() { return (unsigned)__builtin_amdgcn_s_getreg((3 << 11) | 20) & 0xFu; }
#define XB_SPIN(cond, bar) do { unsigned _sp = 0; while (cond) { __builtin_amdgcn_s_sleep(1); \
    if ((++_sp & 255u) == 0u) { if (xb_ld(&(bar)[XB_TMO])) break; if (_sp > XB_SPIN_CAP) { atomicAdd(&(bar)[XB_TMO], 1u); break; } } } } while (0)
struct XcdBarrier { unsigned* bar; unsigned x; volatile LAS unsigned* st; };
__device__ __forceinline__ XcdBarrier xcd_barrier_post(unsigned* bar, volatile LAS unsigned* st) {
    XcdBarrier b; b.bar = bar; b.x = xb_xcc_id(); b.st = st;
    if (threadIdx.x == 0) (void)xb_add(&bar[XB_XCNT(b.x)], 1u);
    return b;
}
__device__ __forceinline__ void xcd_barrier_complete(unsigned* bar, unsigned x, unsigned& nloc, unsigned& nx) {
    const unsigned G = gridDim.x * gridDim.y * gridDim.z;
    unsigned sum, cnt, mine, sp = 0u;
    for (;;) {
        sum = 0u; cnt = 0u; mine = 0u;
#pragma unroll
        for (unsigned j = 0; j < 16; ++j) { const unsigned c = xb_ld(&bar[XB_XCNT(j)]); sum += c; cnt += (c > 0u) ? 1u : 0u; mine = (j == x) ? c : mine; }
        if (sum == G) break;
        __builtin_amdgcn_s_sleep(1);
        if ((++sp & 255u) == 0u) { if (xb_ld(&bar[XB_TMO])) break; if (sp > XB_SPIN_CAP) { atomicAdd(&bar[XB_TMO], 1u); break; } }
    }
    nloc = mine > 0u ? mine : 1u; nx = cnt > 0u ? cnt : 1u;
}
__device__ __forceinline__ void xcd_barrier(const XcdBarrier& b) {
    asm volatile("s_waitcnt vmcnt(0)" ::: "memory");
    __syncthreads();
    if (threadIdx.x == 0) {
        unsigned* bar = b.bar;
        __builtin_amdgcn_s_waitcnt(0);
        unsigned nloc = b.st[0], nx = b.st[1];
        if (nloc == 0u) { xcd_barrier_complete(bar, b.x, nloc, nx); b.st[0] = nloc; b.st[1] = nx; }
        const unsigned old = xb_add(&bar[XB_XSUB(b.x)], 1u);
        const unsigned gen = old / nloc;
        if (old + 1u == (gen + 1u) * nloc) {
            __builtin_amdgcn_fence(__ATOMIC_RELEASE, "agent");
            asm volatile("s_waitcnt vmcnt(0)" ::: "memory");
            const unsigned og = xb_add(&bar[XB_TOP], 1u);
            const unsigned tg = og / nx;
            if (og + 1u == (tg + 1u) * nx) xb_add(&bar[XB_TOPGEN], 1u);
            else XB_SPIN(xb_ld(&bar[XB_TOPGEN]) == tg, bar);
            __builtin_amdgcn_fence(__ATOMIC_ACQUIRE, "agent");
            xb_add(&bar[XB_XGEN(b.x)], 1u);
            asm volatile("s_waitcnt vmcnt(0)" ::: "memory");
        } else {
            XB_SPIN(xb_ld(&bar[XB_XGEN(b.x)]) == gen, bar);
            __builtin_amdgcn_fence(__ATOMIC_ACQUIRE, "agent");
            asm volatile("s_waitcnt vmcnt(0)" ::: "memory");
        }
    }
    __syncthreads();
}

__global__ void __launch_bounds__(NTHREADS, 2) mega(Args a) {
    extern __shared__ __attribute__((aligned(16))) unsigned char lds_raw[];
    LAS unsigned char* lds = (LAS unsigned char*)lds_raw;
    cg::grid_group grid = cg::this_grid();
    const int wave = __builtin_amdgcn_readfirstlane((int)threadIdx.x >> 6);
    const int G = gridDim.x, bx = blockIdx.x;
    const int vcu = (G % 8 == 0) ? (bx % 8) * (G / 8) + bx / 8 : bx;
    const int gw = bx * NWAVES + wave, NGW = G * NWAVES;
    unsigned char* ws = a.ws;
    {
        if (bx == 0) for (int i = threadIdx.x; i < XCD_BAR_WORDS; i += NTHREADS) ((unsigned*)(ws + WS_BAR))[i] = 0u;
        if (threadIdx.x < 2) ((volatile LAS unsigned*)(lds + LDS_MISC))[threadIdx.x] = 0u;
        __syncthreads();
    }

#ifndef NO_P0
    {
        const int tid = fresh_tid(wave);
        LAS float* scv = (LAS float*)lds;
        LAS float* red = (LAS float*)(lds + 49152);
        for (int item = bx; item < 192; item += G) {
            const int l = item / 48, nb = item % 48, c = tid & 127, kq = tid >> 7, n = nb * 128 + c;
            __syncthreads();
            for (int i = tid; i < 12 * 1024; i += NTHREADS) { const int b = i >> 10, k = i & 1023; const float cv = b < 8 ? a.in[2][b * 1024 + k] : a.in[3][(b - 8) * 1024 + k]; scv[k * 12 + b] = siluf_(cv); }
            __syncthreads();
            float acc[12];
#pragma unroll
            for (int b = 0; b < 12; ++b) acc[b] = 0.f;
            const float* wp = a.in[4] + (size_t)l * 1024 * 6144 + (size_t)(kq * 256) * 6144 + n;
            const LAS float* sp = scv + kq * 256 * 12;
#pragma unroll 8
            for (int k = 0; k < 256; ++k) {
                const float w = wp[(size_t)k * 6144];
                const f32x4 s0 = *(const LAS f32x4*)(sp + k * 12), s1 = *(const LAS f32x4*)(sp + k * 12 + 4), s2 = *(const LAS f32x4*)(sp + k * 12 + 8);
                acc[0] += s0[0] * w; acc[1] += s0[1] * w; acc[2] += s0[2] * w; acc[3] += s0[3] * w;
                acc[4] += s1[0] * w; acc[5] += s1[1] * w; acc[6] += s1[2] * w; acc[7] += s1[3] * w;
                acc[8] += s2[0] * w; acc[9] += s2[1] * w; acc[10] += s2[2] * w; acc[11] += s2[3] * w;
            }
#pragma unroll
            for (int b = 0; b < 12; ++b) red[(kq * 12 + b) * 128 + c] = acc[b];
            __syncthreads();
            for (int i = tid; i < 12 * 128; i += NTHREADS) { const int b = i >> 7, cc = i & 127;
                const float v = ((red[(0 * 12 + b) * 128 + cc] + red[(1 * 12 + b) * 128 + cc]) + red[(2 * 12 + b) * 128 + cc]) + red[(3 * 12 + b) * 128 + cc];
                MOD[((size_t)l * 12 + b) * 6144 + nb * 128 + cc] = v + a.in[5][l * 6144 + nb * 128 + cc]; }
        }
        for (int i = bx * NTHREADS + tid; i < 8192 * 32; i += G * NTHREADS) {
            const int pos = i >> 5, fi = i & 31; const float inv = 1.0f / powf(10000.0f, (float)fi * (1.0f / 32.0f)); const float ang = (float)pos * inv;
            ROPE[(size_t)i * 2] = cosf(ang); ROPE[(size_t)i * 2 + 1] = sinf(ang);
        }
    }
#endif
    grid.sync();
    const XcdBarrier xbar = xcd_barrier_post((unsigned*)(ws + WS_BAR), (volatile LAS unsigned*)(lds + LDS_MISC));

    for (int l = 0; l < DEPTH; ++l) {
        for (int grp = 0; grp < 2; ++grp) {
            float* xg = a.out + (size_t)grp * MG * D;
            const int Lshift = grp ? 13 : 12, L = 1 << Lshift, bbase = grp ? 8 : 0, nbat = grp ? 4 : 8, NC = L >> 4;
            const float* modl = MOD + ((size_t)l * 12 + bbase) * 6144;

            if (l == 0 && grp == 0) {
                if (bx < 32) { for (int g = bx; g < 32; g += G) ssm_gen(a, 0, g, (LAS float*)lds, BTS, BTY, A16, wave); }
                else convert_job(a, ws, 0, 3, lds, wave, (bx - 32) * NWAVES + wave, (G - 32) * NWAVES);
            }
            norm_rows(l == 0 ? a.in[grp] : xg, Hb, a.in[6] + l * 1024, modl, 0, 1024, Lshift, gw, NGW, 0);
            xcd_barrier(xbar);

#ifndef NO_P2
            {
                pg8::GridOrder S; S.init(MG, INCOLS, G, bx, Hb, WIN, 1024, 1024);
                EpiInproj E{Qb, Kb, Vb, SSMA, GA, GS, ROPE, L - 1};
                pg8::gemm_phase(lds, wave, 1024, 1024, 1024, S, E);
            }
#endif
            xcd_barrier(xbar);

#ifndef NO_P3
            {
                pg8::SsmOrder S{(const char*)SSMA, (const char*)BTS, (size_t)256 * 256 * 2, G, vcu};
                EpiS E{Sb};
                pg8::gemm_phase(lds, wave, 256, 512, 256, S, E);
            }
#endif
            xcd_barrier(xbar);

#ifndef NO_P4
            {
                const int nitem = nbat * 64;
                const int lane = fresh_lane();
                for (int it = wave * G + bx; it < nitem; it += NGW) {
                    const int dir = it & 1, g = (it >> 1) & 31, b = it >> 6;
                    const float ar = A16[((g * 2 + dir) * 64 + lane) * 2], ai = A16[((g * 2 + dir) * 64 + lane) * 2 + 1];
                    float hr = 0.f, hi = 0.f;
                    const size_t rbase = (size_t)g * NROW + (size_t)b * NC;
                    for (int c0 = 0; c0 < NC; c0 += 16) {
                        float sr[16], si[16];
#pragma unroll
                        for (int e = 0; e < 16; ++e) { const int c = dir ? NC - 1 - (c0 + e) : c0 + e; const float* sp = Sb + (rbase + c) * 256 + dir * 128 + lane; sr[e] = sp[0]; si[e] = sp[64]; }
#pragma unroll
                        for (int e = 0; e < 16; ++e) { const int c = dir ? NC - 1 - (c0 + e) : c0 + e; bf16_t* hp = SSMA + (rbase + c) * 512 + 256 + dir * 128 + lane;
                            hp[0] = (bf16_t)(cvt_pk_bf16(hr, 0.f) & 0xffffu); hp[64] = (bf16_t)(cvt_pk_bf16(hi, 0.f) & 0xffffu);
                            const float t = ar * hr - ai * hi + sr[e]; hi = ar * hi + ai * hr + si[e]; hr = t; }
                    }
                }
                if (wave >= 2) {
                    if (grp == 0) convert_job(a, ws, l, 4, lds, wave, bx * 6 + wave - 2, G * 6);
                    else if (l + 1 < DEPTH) convert_job(a, ws, l + 1, 1, lds, wave, bx * 6 + wave - 2, G * 6);
                }
            }
#endif
            xcd_barrier(xbar);

#ifndef NO_P5
            {
                const float lam_init = __uint_as_float(__builtin_amdgcn_readfirstlane(l == 0 ? 0x3e4ccccdu : l == 1 ? 0x3eb60549u : l == 2 ? 0x3ef1014cu : 0x3f0e59d5u));
                float lam;
                { const int lane = fresh_lane();
                  const float q1 = a.in[8][l * 64 + lane] * a.in[9][l * 64 + lane], q2 = a.in[10][l * 64 + lane] * a.in[11][l * 64 + lane];
                  lam = expf(wave_sum(q1)) - expf(wave_sum(q2)) + lam_init; }
                const int NQB = L >> 8;
#ifndef NO_P5A
                for (int unit = vcu; unit < 512; unit += G) {
                    const int bh = unit / NQB, qb = unit % NQB, b = bh >> 2, h = bh & 3;
                    const size_t row0 = (size_t)b * L + (size_t)qb * 256;
                    f32x16 o[4]; float rli[16];
                    att::attn_pass(Qb + row0 * 512 + h * 128, Kb + (size_t)b * L * 512 + h * 128, Vb + (size_t)b * L * 512 + h * 128, L, (LAS char*)lds, wave, o, rli);
                    {
                        f32x4* p = (f32x4*)STASH + (size_t)wave * 1024 + (fresh_lane());
#pragma unroll
                        for (int d0 = 0; d0 < 4; ++d0)
#pragma unroll
                            for (int r4 = 0; r4 < 4; ++r4) {
                                f32x4 v; v[0] = o[d0][4 * r4] * rli[4 * r4]; v[1] = o[d0][4 * r4 + 1] * rli[4 * r4 + 1]; v[2] = o[d0][4 * r4 + 2] * rli[4 * r4 + 2]; v[3] = o[d0][4 * r4 + 3] * rli[4 * r4 + 3];
                                p[(d0 * 4 + r4) * 64] = v; }
                    }
                    att::attn_pass(Qb + row0 * 512 + h * 128 + 64, Kb + (size_t)b * L * 512 + h * 128 + 64, Vb + (size_t)b * L * 512 + h * 128, L, (LAS char*)lds, wave, o, rli);
                    const int lane = fresh_lane(), r32 = lane & 31, hi = lane >> 5;
                    float ss[16];
#pragma unroll
                    for (int r = 0; r < 16; ++r) ss[r] = 0.f;
                    {
                        const f32x4* p = (const f32x4*)STASH + (size_t)wave * 1024 + lane;
#pragma unroll
                        for (int d0 = 0; d0 < 4; ++d0)
#pragma unroll
                            for (int r4 = 0; r4 < 4; ++r4) { const f32x4 t = p[(d0 * 4 + r4) * 64];
#pragma unroll
                                for (int e = 0; e < 4; ++e) { const int r = 4 * r4 + e; const float v = t[e] - lam * (o[d0][r] * rli[r]); o[d0][r] = v; ss[r] += v * v; } }
                    }
                    float sg[4];
#pragma unroll
                    for (int d0 = 0; d0 < 4; ++d0) sg[d0] = a.in[12][l * 128 + d0 * 32 + r32] * (1.0f - lam_init);
#pragma unroll
                    for (int r = 0; r < 16; ++r) {
                        float s = ss[r];
                        s = half_sum(s);
                        const float rs = rsqrtf(s * (1.0f / 128.0f) + EPS);
                        bf16_t* op = Qb + (row0 + wave * 32 + att::crow(r, hi)) * 512 + h * 128 + r32;
#pragma unroll
                        for (int d0 = 0; d0 < 4; ++d0) op[d0 * 32] = (bf16_t)(cvt_pk_bf16(o[d0][r] * rs * sg[d0], 0.f) & 0xffffu);
                    }
                }
#endif
                __syncthreads();
#ifndef NO_P5Y
                pg8::SsmOrder S{(const char*)SSMA, (const char*)BTY, (size_t)256 * 512 * 2, G, vcu};
                EpiY E{SSMA, Zb, a.in[21] + l * 512};
                pg8::gemm_phase(lds, wave, 512, 512, 512, S, E);
#endif
            }
#endif
            xcd_barrier(xbar);

#ifndef NO_P6
            {
                pg8::MergeOrder S{(const char*)Zb, (const char*)Qb, (const char*)WGLU, (const char*)WATT, G, vcu};
                EpiMerge E{GA, GS, a.in[23] + l * 2048};
                pg8::gemm_phase(lds, wave, 512, 512, 512, S, E);
            }
#endif
            xcd_barrier(xbar);

#ifndef NO_P7
            {
                pg8::GridOrder S; S.init(MG, D, G, bx, GA, WO, 1024, 1024);
                EpiResid E{l == 0 ? a.in[grp] : xg, xg, modl + 2048, Lshift};
                pg8::gemm_phase(lds, wave, 1024, 1024, 1024, S, E);
            }
#endif
            xcd_barrier(xbar);

            if (grp == 1 && l + 1 < DEPTH) {
                if (bx < 32) { for (int g = bx; g < 32; g += G) ssm_gen(a, l + 1, g, (LAS float*)lds, BTS, BTY, A16, wave); }
                else convert_job(a, ws, l + 1, 2, lds, wave, (bx - 32) * NWAVES + wave, (G - 32) * NWAVES);
            }
            norm_rows(xg, Hb, a.in[25] + l * 1024, modl, 3072, 4096, Lshift, gw, NGW, 0);
            xcd_barrier(xbar);

#ifndef NO_P9
            {
                pg8::GridOrder S; S.init(MG, 2 * DFF, G, bx, Hb, WFI, 1024, 1024);
                EpiFfnIn E{ACT};
                pg8::gemm_phase(lds, wave, 1024, 1024, 1024, S, E);
            }
#endif
            xcd_barrier(xbar);

#ifndef NO_P10
            {
                pg8::GridOrder S; S.init(MG, D, G, bx, ACT, WFO, DFF, DFF);
                EpiResid E{xg, xg, modl + 5120, Lshift};
                pg8::gemm_phase(lds, wave, DFF, DFF, DFF, S, E);
            }
#endif
            xcd_barrier(xbar);
        }
    }

    {
        const int lane = fresh_lane();
        f32x4 gv[4];
#pragma unroll
        for (int j = 0; j < 4; ++j) gv[j] = *(const f32x4*)(a.in[28] + 4 * lane + 256 * j);
        for (int row = gw; row < 2 * MG; row += 4 * NGW) {
            f32x4 v[4][4]; float sc[4];
#pragma unroll
            for (int q = 0; q < 4; ++q) { const int r = row + q * NGW < 2 * MG ? row + q * NGW : row; const f32x4* xr = (const f32x4*)(a.out + (size_t)r * D) + lane;
#pragma unroll
                for (int j = 0; j < 4; ++j) v[q][j] = xr[64 * j]; }
#pragma unroll
            for (int q = 0; q < 4; ++q) { float t = 0.f;
#pragma unroll
                for (int j = 0; j < 4; ++j) t += (v[q][j].x * v[q][j].x + v[q][j].y * v[q][j].y) + (v[q][j].z * v[q][j].z + v[q][j].w * v[q][j].w);
                sc[q] = rsqrtf(wave_sum(t) * (1.f / D) + EPS); }
#pragma unroll
            for (int q = 0; q < 4; ++q) { if (row + q * NGW < 2 * MG) { f32x4* xr = (f32x4*)(a.out + (size_t)(row + q * NGW) * D) + lane;
#pragma unroll
                for (int j = 0; j < 4; ++j) xr[64 * j] = v[q][j] * sc[q] * gv[j]; } }
        }
    }
}

extern "C" void kernel_launch(void* const* d_in, const int* in_sizes, int n_in, void* d_out, int out_size, void* d_ws, size_t ws_size, hipStream_t stream) {
    static int grid = 0;
    if (grid == 0) {
        if (n_in != 29 || out_size != 2 * MG * D || ws_size < WS_END) { fprintf(stderr, "kernel_launch: unexpected shapes (n_in %d out %d ws %zu)\n", n_in, out_size, ws_size); grid = -1; return; }
        int dev = 0, cus = 0, per_cu = 0;
        if (hipGetDevice(&dev) != hipSuccess || hipDeviceGetAttribute(&cus, hipDeviceAttributeMultiprocessorCount, dev) != hipSuccess) { grid = -1; return; }
        if (hipFuncSetAttribute((const void*)mega, hipFuncAttributeMaxDynamicSharedMemorySize, LDS_BYTES) != hipSuccess) { fprintf(stderr, "kernel_launch: hipFuncSetAttribute failed\n"); grid = -1; return; }
        if (hipOccupancyMaxActiveBlocksPerMultiprocessor(&per_cu, (const void*)mega, NTHREADS, LDS_BYTES) != hipSuccess || per_cu < 1) { fprintf(stderr, "kernel_launch: occupancy query gave %d\n", per_cu); per_cu = 1; }
        (void)hipGetLastError();
        grid = cus * per_cu;
    }
    if (grid < 0) return;
    Args a{};
    for (int i = 0; i < 29; ++i) a.in[i] = (const float*)d_in[i];
    a.out = (float*)d_out; a.ws = (unsigned char*)d_ws;
    void* args[] = {&a};
    const hipError_t e = hipLaunchCooperativeKernel((const void*)mega, dim3(grid), dim3(NTHREADS), args, LDS_BYTES, stream);
    if (e != hipSuccess) fprintf(stderr, "kernel_launch: cooperative launch failed: %s (grid %d)\n", hipGetErrorString(e), grid);
}
```

```cpp
#include <hip/hip_runtime.h>
#include <hip/hip_cooperative_groups.h>
#include <cstdio>
#include <cstdint>
namespace cg = cooperative_groups;

#define LAS __attribute__((address_space(3)))
typedef unsigned short bf16_t;
typedef short bf16x8 __attribute__((ext_vector_type(8)));
typedef short s16x4 __attribute__((ext_vector_type(4)));
typedef float f32x4 __attribute__((ext_vector_type(4)));
typedef float f32x2 __attribute__((ext_vector_type(2)));
typedef float f32x16 __attribute__((ext_vector_type(16)));
typedef unsigned u32x4 __attribute__((ext_vector_type(4)));
typedef unsigned u32x2 __attribute__((ext_vector_type(2)));

constexpr int D = 1024, DEPTH = 4, DFF = 2816, INCOLS = 4096;
constexpr int MG = 32768;
constexpr int NROW = MG / 16;
constexpr float EPS = 1e-6f;
constexpr float QSC = 0.125f * 1.4426950408889634f;
constexpr int NTHREADS = 512, NWAVES = 8;

constexpr size_t MiB = 1u << 20;
constexpr size_t WS_MOD = 0;
constexpr size_t WS_ROPE = 2 * MiB;
constexpr size_t WS_A16 = 4 * MiB;
constexpr size_t WS_WIN = 5 * MiB;
constexpr size_t WS_WATT = 13 * MiB;
constexpr size_t WS_WGLU = 14 * MiB;
constexpr size_t WS_WO = 16 * MiB;
constexpr size_t WS_WFI = 18 * MiB;
constexpr size_t WS_WFO = 29 * MiB;
constexpr size_t WS_BTS = 35 * MiB;
constexpr size_t WS_BTY = 39 * MiB;
constexpr size_t WS_STASH = 47 * MiB;
constexpr size_t WS_H = 111 * MiB;
constexpr size_t WS_Q = 175 * MiB;
constexpr size_t WS_K = 207 * MiB;
constexpr size_t WS_V = 239 * MiB;
constexpr size_t WS_SSMA = 271 * MiB;
constexpr size_t WS_GA = 335 * MiB;
constexpr size_t WS_GS = 399 * MiB;
constexpr size_t WS_ACT = 175 * MiB;
constexpr size_t WS_END = 463 * MiB;
constexpr size_t WS_BAR = 4 * MiB + 768 * 1024;
constexpr int LDS_MISC = 131072;
constexpr int LDS_BYTES = 135168;

struct Args { const float* in[29]; float* out; unsigned char* ws; };

__device__ __forceinline__ int fresh_lane() { int l; asm volatile("v_mbcnt_lo_u32_b32 %0, -1, 0\n\tv_mbcnt_hi_u32_b32 %0, -1, %0" : "=v"(l)); return l; }
__device__ __forceinline__ int fresh_tid(int wave) { return wave * 64 + fresh_lane(); }
typedef __attribute__((address_space(1))) unsigned char gas_u8;
__device__ __forceinline__ unsigned char* fresh_ptr(unsigned char* p) { gas_u8* g = (gas_u8*)p; asm volatile("" : "+s"(g)); return (unsigned char*)g; }
typedef __bf16 bf16x2_t __attribute__((ext_vector_type(2)));
__device__ __forceinline__ unsigned cvt_pk_bf16(float lo, float hi) { const f32x2 v = {lo, hi}; const bf16x2_t b = __builtin_convertvector(v, bf16x2_t); return __builtin_bit_cast(unsigned, b); }
__device__ __forceinline__ float bf2f(unsigned short b) { return __uint_as_float(((unsigned)b) << 16); }
__device__ __forceinline__ float bflo(unsigned w) { return __uint_as_float(w << 16); }
__device__ __forceinline__ float bfhi(unsigned w) { return __uint_as_float(w & 0xffff0000u); }
__device__ __forceinline__ float sigmoidf_(float x) { return __builtin_amdgcn_rcpf(1.0f + __expf(-x)); }
__device__ __forceinline__ float siluf_(float x) { return x * __builtin_amdgcn_rcpf(1.0f + __expf(-x)); }
__device__ __forceinline__ float gelu_tanh(float y) { const float z = 0.7978845608028654f * (y + 0.044715f * y * y * y); const float t = 1.0f - 2.0f * __builtin_amdgcn_rcpf(1.0f + __expf(2.0f * z)); return 0.5f * y * (1.0f + t); }
template <int M> __device__ __forceinline__ float swz_xor(float v) { return __int_as_float(__builtin_amdgcn_ds_swizzle(__float_as_int(v), (M << 10) | 0x1f)); }
__device__ __forceinline__ float half_sum(float v) { v += swz_xor<1>(v); v += swz_xor<2>(v); v += swz_xor<4>(v); v += swz_xor<8>(v); v += swz_xor<16>(v); return v; }
__device__ __forceinline__ float wave_sum(float v) {
    v = half_sum(v);
    auto rr = __builtin_amdgcn_permlane32_swap(__float_as_uint(v), __float_as_uint(v), false, false);
    return __uint_as_float(rr[0]) + __uint_as_float(rr[1]);
}
__device__ __forceinline__ u32x4 pack8(f32x4 a, f32x4 b) { u32x4 w; w.x = cvt_pk_bf16(a[0], a[1]); w.y = cvt_pk_bf16(a[2], a[3]); w.z = cvt_pk_bf16(b[0], b[1]); w.w = cvt_pk_bf16(b[2], b[3]); return w; }

namespace pg8 {
constexpr int BM = 256, BK = 64, HALF = 128, HTB = HALF * BK * 2, STAGE_BYTES = 8 * HTB, NXCD = 8, WGM = 8;
__host__ __device__ __forceinline__ int lds_byte(int r, int c) { const int st = (r >> 4) * 2 + (c >> 5), rr = r & 15, cc = c & 31, ob = rr * 64 + cc * 2; return st * 1024 + (ob ^ (((ob >> 9) & 1) << 5)); }
__host__ __device__ __forceinline__ void stage_rc(int b, int& R, int& C) { const int st = b / 1024, sb = b % 1024, swz = sb ^ (((sb >> 9) & 1) << 5); R = (st >> 1) * 16 + swz / 64; C = (st & 1) * 32 + (swz % 64) / 2; }
__host__ __device__ __forceinline__ int perm32(int rho) { const int n = rho >> 4, i = rho & 15; return 8 * (i >> 2) + 4 * n + (i & 3); }
struct Unit { const char* a; const char* b; int pm, pn, aux; };
template <class Epi, class Sched>
__device__ __forceinline__ void gemm_phase(LAS unsigned char* lds, const int wid, const int K, const int lda, const int ldb, const Sched& S, const Epi& E) {
    const int lane = fresh_lane(), tid = wid * 64 + lane, wr = wid >> 2, wc = wid & 3, fr = lane & 15, fq = lane >> 4;
    const int nt = K / BK;
    unsigned voffA, voffB;
    { int R, C; stage_rc(tid * 16, R, C); const int Rb = Epi::PERM ? ((R & ~31) + perm32(R & 31)) : R;
      voffA = (unsigned)(R * lda + C) * 2u; voffB = (unsigned)(Rb * ldb + C) * 2u; }
    const size_t qvoffA = (size_t)64 * lda * 2, qvoffB = (size_t)64 * ldb * 2;
    const size_t kstep = (size_t)(BK * 2);
    const size_t hA = (size_t)HALF * lda * 2, hB = (size_t)HALF * ldb * 2;
    const unsigned ldsw = (unsigned)wid * 1024u;
    const int aoff = lds_byte(wr * 64 + fr, fq * 8), boff = lds_byte(wc * 32 + fr, fq * 8);
#define PG8_SA(b, h) (((b) * 2 + (h)) * HTB)
#define PG8_SB(b, h) ((4 + (b) * 2 + (h)) * HTB)
#define PG8_STAGE(bufoff, gbase, voff) do { _Pragma("unroll") for (int _i = 0; _i < 2; ++_i) \
        __builtin_amdgcn_global_load_lds((const unsigned*)((const char*)(gbase) + (size_t)_i * q##voff + (voff)), (LAS unsigned*)(lds + (bufoff) + ldsw + _i * 8192), 16, 0, 0); } while (0)
#define PG8_LDA(dst, b, h) do { _Pragma("unroll") for (int m = 0; m < 4; ++m) _Pragma("unroll") for (int k = 0; k < 2; ++k) dst[m][k] = *(const LAS bf16x8*)(lds + PG8_SA(b, h) + aoff + m * 2048 + k * 1024); } while (0)
#define PG8_LDB(dst, b, h) do { _Pragma("unroll") for (int n = 0; n < 2; ++n) _Pragma("unroll") for (int k = 0; k < 2; ++k) dst[n][k] = *(const LAS bf16x8*)(lds + PG8_SB(b, h) + boff + n * 2048 + k * 1024); } while (0)
#define PG8_MMA(ai, bj, At, Bt) do { __builtin_amdgcn_s_setprio(1); _Pragma("unroll") for (int m = 0; m < 4; ++m) _Pragma("unroll") for (int n = 0; n < 2; ++n) _Pragma("unroll") for (int k = 0; k < 2; ++k) \
        acc[ai][bj][m][n] = __builtin_amdgcn_mfma_f32_16x16x32_bf16(Bt[n][k], At[m][k], acc[ai][bj][m][n], 0, 0, 0); __builtin_amdgcn_s_setprio(0); } while (0)
#define PG8_WAIT_V(n) asm volatile("s_waitcnt vmcnt(" #n ")" ::: "memory")
#define PG8_WAIT_L(n) asm volatile("s_waitcnt lgkmcnt(" #n ")" ::: "memory")
#define PG8_BAR __builtin_amdgcn_s_barrier()
#define PG8_SCHED __builtin_amdgcn_sched_barrier(0)
    Unit cur, nxt; int ui = 0;
    if (!S.next(0, cur)) return;
    f32x4 acc[2][2][4][2];
#pragma unroll
    for (int a = 0; a < 2; ++a)
#pragma unroll
        for (int b = 0; b < 2; ++b)
#pragma unroll
            for (int m = 0; m < 4; ++m)
#pragma unroll
                for (int n = 0; n < 2; ++n) acc[a][b][m][n] = (f32x4){0.f, 0.f, 0.f, 0.f};
    bf16x8 At[4][2], B0[2][2], B1[2][2];
    const char* cA = cur.a; const char* cB = cur.b;
    PG8_STAGE(PG8_SB(0, 0), cB, voffB); PG8_STAGE(PG8_SB(0, 1), cB + hB, voffB); PG8_STAGE(PG8_SA(0, 0), cA, voffA); PG8_STAGE(PG8_SA(0, 1), cA + hA, voffA);
    if (wr == 1) PG8_BAR;
    PG8_WAIT_V(2); PG8_BAR;
    PG8_STAGE(PG8_SB(1, 0), cB + kstep, voffB); PG8_STAGE(PG8_SA(1, 0), cA + kstep, voffA); PG8_STAGE(PG8_SB(1, 1), cB + hB + kstep, voffB);
    PG8_WAIT_V(6); PG8_BAR;
    for (;;) {
        const bool has_next = S.next(ui + 1, nxt);
        const char* nA = has_next ? nxt.a : cA; const char* nB = has_next ? nxt.b : cB;
        for (int t = 0; t < nt; t += 2) {
            const bool last = (t == nt - 2);
            const char* a1 = cA + (size_t)(t + 1) * kstep;
            const char* a2 = last ? nA : cA + (size_t)(t + 2) * kstep; const char* b2 = last ? nB : cB + (size_t)(t + 2) * kstep;
            const char* a3 = a2 + kstep; const char* b3 = b2 + kstep;
            PG8_LDB(B0, 0, 0); PG8_LDB(B1, 0, 1); PG8_SCHED; PG8_LDA(At, 0, 0); PG8_STAGE(PG8_SA(1, 1), a1 + hA, voffA);
            PG8_WAIT_V(8); PG8_WAIT_L(0); PG8_BAR; PG8_MMA(0, 0, At, B0); PG8_MMA(0, 1, At, B1); PG8_BAR; PG8_SCHED;
            PG8_LDA(At, 0, 1); PG8_STAGE(PG8_SB(0, 0), b2, voffB); PG8_STAGE(PG8_SB(0, 1), b2 + hB, voffB); PG8_STAGE(PG8_SA(0, 0), a2, voffA);
            PG8_WAIT_V(8); PG8_WAIT_L(0); PG8_BAR; PG8_MMA(1, 0, At, B0); PG8_MMA(1, 1, At, B1); PG8_BAR; PG8_SCHED;
            PG8_LDB(B0, 1, 0); PG8_LDB(B1, 1, 1); PG8_SCHED; PG8_LDA(At, 1, 0); PG8_STAGE(PG8_SA(0, 1), a2 + hA, voffA);
            PG8_WAIT_V(8); PG8_WAIT_L(0); PG8_BAR; PG8_MMA(0, 0, At, B0); PG8_MMA(0, 1, At, B1); PG8_BAR; PG8_SCHED;
            PG8_LDA(At, 1, 1); PG8_STAGE(PG8_SB(1, 0), b3, voffB); PG8_STAGE(PG8_SB(1, 1), b3 + hB, voffB); PG8_STAGE(PG8_SA(1, 0), a3, voffA);
            PG8_WAIT_V(8); PG8_WAIT_L(0); PG8_BAR; PG8_MMA(1, 0, At, B0); PG8_MMA(1, 1, At, B1); PG8_BAR; PG8_SCHED;
        }
        if (wr == 0) PG8_BAR;
        E(acc, cur, wr, wc, fr, fq);
        if (!has_next) break;
#pragma unroll
        for (int a = 0; a < 2; ++a)
#pragma unroll
            for (int b = 0; b < 2; ++b)
#pragma unroll
                for (int m = 0; m < 4; ++m)
#pragma unroll
                    for (int n = 0; n < 2; ++n) acc[a][b][m][n] = (f32x4){0.f, 0.f, 0.f, 0.f};
        cur = nxt; cA = nA; cB = nB; ++ui;
        if (wr == 1) PG8_BAR;
    }
    PG8_WAIT_V(0);
    PG8_BAR;
#undef PG8_SA
#undef PG8_SB
#undef PG8_STAGE
#undef PG8_LDA
#undef PG8_LDB
#undef PG8_MMA
#undef PG8_WAIT_V
#undef PG8_WAIT_L
#undef PG8_BAR
#undef PG8_SCHED
}

struct GridOrder {
    int nM, nN, nwg, G, c; const char* A; const char* B; size_t ta, tb;
    __device__ void init(int M, int N, int G_, int c_, const void* A_, const void* B_, int lda, int ldb) { nM = M / BM; nN = N / BM; nwg = nM * nN; G = G_; c = c_; A = (const char*)A_; B = (const char*)B_; ta = (size_t)BM * lda * 2; tb = (size_t)BM * ldb * 2; }
    __device__ bool next(int i, Unit& u) const {
        const long L = (long)i * G + c; if (L >= nwg) return false;
        int wgid = (int)L; { const int q = nwg / NXCD, r = nwg % NXCD, xcd = wgid % NXCD, off = wgid / NXCD; wgid = (xcd < r ? xcd * (q + 1) : r * (q + 1) + (xcd - r) * q) + off; }
        const int nig = WGM * nN, gid = wgid / nig, fm = gid * WGM, gsz = (nM - fm) < WGM ? (nM - fm) : WGM;
        u.pm = fm + ((wgid % nig) % gsz); u.pn = (wgid % nig) / gsz; u.aux = 0;
        u.a = A + (size_t)u.pm * ta; u.b = B + (size_t)u.pn * tb; return true;
    }
};
struct SsmOrder {
    const char* A; const char* B; size_t tb; int G, c;
    __device__ bool next(int i, Unit& u) const {
        const int w = i * G + c; if (w >= 256) return false;
        u.pm = w; u.pn = 0; u.aux = 0; u.a = A + (size_t)w * 256 * 512 * 2; u.b = B + (size_t)(w >> 3) * tb; return true;
    }
};
struct MergeOrder {
    const char* Z; const char* ON; const char* WG; const char* WA; int G, c;
    __device__ bool next(int i, Unit& u) const {
        const int item = c + (i / 6) * G; if (item >= 256) return false;
        const int sub = i % 6, panel = item >> 1, half = item & 1, jj = half * 2 + sub / 3, t = sub % 3;
        u.pm = panel;
        if (t < 2) { const int gu = 2 * jj + t; u.pn = gu; u.aux = 0; u.a = Z + (size_t)panel * 256 * 512 * 2; u.b = WG + (size_t)gu * 256 * 512 * 2; }
        else { u.pn = jj; u.aux = 1; u.a = ON + (size_t)panel * 256 * 512 * 2; u.b = WA + (size_t)jj * 256 * 512 * 2; }
        return true;
    }
};
}
using pg8::Unit;
typedef f32x4 Acc[2][2][4][2];

struct EpiInproj {
    static constexpr bool PERM = true;
    bf16_t *Q, *Kb, *V, *SSMA, *GA, *GS; const float* rope; int Lmask;
    __device__ __forceinline__ void operator()(const Acc& acc, const Unit& u, int wr, int wc, int fr, int fq) const {
        { const int ln = fresh_lane(); fr = ln & 15; fq = ln >> 4; }
        const int reg = u.pn;
        if (reg < 4) {
            const int i0 = ((wc * 32 + fq * 8) & 63) >> 1;
            bf16_t* base = (reg < 2 ? Q + u.pn * 256 : Kb + (u.pn * 256 - 512)) + wc * 32 + fq * 8;
#pragma unroll
            for (int ai = 0; ai < 2; ++ai) {
                const int row0 = u.pm * 256 + ai * 128 + wr * 64 + fr;
                f32x4 r0[4], r1[4];
#pragma unroll
                for (int m = 0; m < 4; ++m) { const f32x4* rp = (const f32x4*)(rope + ((size_t)((row0 + m * 16) & Lmask) * 32 + i0) * 2); r0[m] = rp[0]; r1[m] = rp[1]; }
#pragma unroll
                for (int m = 0; m < 4; ++m) asm volatile("" : "+v"(r0[m]), "+v"(r1[m]));
#pragma unroll
                for (int m = 0; m < 4; ++m)
#pragma unroll
                    for (int bj = 0; bj < 2; ++bj) {
                        const f32x4 v0 = acc[ai][bj][m][0], v1 = acc[ai][bj][m][1];
                        f32x4 w0, w1;
                        w0[0] = v0[0] * r0[m][0] - v0[1] * r0[m][1]; w0[1] = v0[1] * r0[m][0] + v0[0] * r0[m][1];
                        w0[2] = v0[2] * r0[m][2] - v0[3] * r0[m][3]; w0[3] = v0[3] * r0[m][2] + v0[2] * r0[m][3];
                        w1[0] = v1[0] * r1[m][0] - v1[1] * r1[m][1]; w1[1] = v1[1] * r1[m][0] + v1[0] * r1[m][1];
                        w1[2] = v1[2] * r1[m][2] - v1[3] * r1[m][3]; w1[3] = v1[3] * r1[m][2] + v1[2] * r1[m][3];
                        if (reg < 2) { w0 = w0 * QSC; w1 = w1 * QSC; }
                        *(u32x4*)(base + (size_t)(row0 + m * 16) * 512 + bj * 128) = pack8(w0, w1);
                    }
            }
            return;
        }
#pragma unroll
        for (int ai = 0; ai < 2; ++ai)
#pragma unroll
            for (int m = 0; m < 4; ++m) {
                const int row = u.pm * 256 + ai * 128 + wr * 64 + m * 16 + fr;
#pragma unroll
                for (int bj = 0; bj < 2; ++bj) {
                    const int c0 = u.pn * 256 + bj * 128 + wc * 32 + fq * 8;
                    f32x4 v0 = acc[ai][bj][m][0], v1 = acc[ai][bj][m][1];
                    bf16_t* dst;
                    if (reg < 6) {
                        dst = V + (size_t)row * 512 + (c0 - 1024);
                    } else if (reg < 8) {
                        const int c = c0 - 1536, g = c >> 4, ch0 = c & 15;
                        dst = SSMA + ((size_t)(g * NROW + (row >> 4)) * 512 + (row & 15) * 16 + ch0);
                    } else {
#pragma unroll
                        for (int i = 0; i < 4; ++i) { v0[i] = sigmoidf_(v0[i]); v1[i] = sigmoidf_(v1[i]); }
                        dst = (reg < 12 ? GA + (c0 - 2048) : GS + (c0 - 3072)) + (size_t)row * 1024;
                    }
                    *(u32x4*)dst = pack8(v0, v1);
                }
            }
    }
};
struct EpiResid {
    static constexpr bool PERM = false;
    const float* xr; float* x; const float* gt; int Lshift;
    __device__ __forceinline__ void operator()(const Acc& acc, const Unit& u, int wr, int wc, int fr, int fq) const {
        { const int ln = fresh_lane(); fr = ln & 15; fq = ln >> 4; }
        const int col0 = u.pn * 256 + wc * 32 + fq * 4;
#pragma unroll
        for (int ai = 0; ai < 2; ++ai) {
            const int row0 = u.pm * 256 + ai * 128 + wr * 64 + fr; const int b = row0 >> Lshift;
            float* xp = x + (size_t)row0 * 1024 + col0; const float* xq = xr + (size_t)row0 * 1024 + col0;
            f32x4 xv[4][2][2], g4[2][2];
#pragma unroll
            for (int bj = 0; bj < 2; ++bj)
#pragma unroll
                for (int n = 0; n < 2; ++n) g4[bj][n] = *(const f32x4*)(gt + (size_t)b * 6144 + col0 + bj * 128 + n * 16);
#pragma unroll
            for (int m = 0; m < 4; ++m)
#pragma unroll
                for (int bj = 0; bj < 2; ++bj)
#pragma unroll
                    for (int n = 0; n < 2; ++n) xv[m][bj][n] = *(const f32x4*)(xq + (size_t)m * 16 * 1024 + bj * 128 + n * 16);
#pragma unroll
            for (int m = 0; m < 4; ++m)
#pragma unroll
                for (int bj = 0; bj < 2; ++bj)
#pragma unroll
                    for (int n = 0; n < 2; ++n) asm volatile("" : "+v"(xv[m][bj][n]));
#pragma unroll
            for (int m = 0; m < 4; ++m)
#pragma unroll
                for (int bj = 0; bj < 2; ++bj)
#pragma unroll
                    for (int n = 0; n < 2; ++n) *(f32x4*)(xp + (size_t)m * 16 * 1024 + bj * 128 + n * 16) = xv[m][bj][n] + g4[bj][n] * acc[ai][bj][m][n];
        }
    }
};
struct EpiFfnIn {
    static constexpr bool PERM = true;
    bf16_t* ACT;
    __device__ __forceinline__ void operator()(const Acc& acc, const Unit& u, int wr, int wc, int fr, int fq) const {
        { const int ln = fresh_lane(); fr = ln & 15; fq = ln >> 4; }
#pragma unroll
        for (int ai = 0; ai < 2; ++ai)
#pragma unroll
            for (int m = 0; m < 4; ++m) {
                const int row = u.pm * 256 + ai * 128 + wr * 64 + m * 16 + fr; const int c0 = u.pn * 128 + wc * 32 + fq * 8;
                f32x4 a0, a1;
#pragma unroll
                for (int i = 0; i < 4; ++i) { a0[i] = siluf_(acc[ai][0][m][0][i]) * acc[ai][1][m][0][i]; a1[i] = siluf_(acc[ai][0][m][1][i]) * acc[ai][1][m][1][i]; }
                *(u32x4*)(ACT + (size_t)row * DFF + c0) = pack8(a0, a1);
            }
    }
};
struct EpiS {
    static constexpr bool PERM = false;
    float* S;
    __device__ __forceinline__ void operator()(const Acc& acc, const Unit& u, int wr, int wc, int fr, int fq) const {
        { const int ln = fresh_lane(); fr = ln & 15; fq = ln >> 4; }
#pragma unroll
        for (int ai = 0; ai < 2; ++ai)
#pragma unroll
            for (int m = 0; m < 4; ++m) {
                const size_t row = (size_t)u.pm * 256 + ai * 128 + wr * 64 + m * 16 + fr;
#pragma unroll
                for (int bj = 0; bj < 2; ++bj)
#pragma unroll
                    for (int n = 0; n < 2; ++n) *(f32x4*)(S + row * 256 + bj * 128 + wc * 32 + n * 16 + fq * 4) = acc[ai][bj][m][n];
            }
    }
};
struct EpiY {
    static constexpr bool PERM = true;
    const bf16_t* SSMA; bf16_t* Z; const float* dskip;
    __device__ __forceinline__ void operator()(const Acc& acc, const Unit& u, int wr, int wc, int fr, int fq) const {
        { const int ln = fresh_lane(); fr = ln & 15; fq = ln >> 4; }
        const int g = u.pm >> 3;
        const f32x4 d0 = *(const f32x4*)(dskip + g * 16 + 8 * (fq & 1)), d1 = *(const f32x4*)(dskip + g * 16 + 8 * (fq & 1) + 4);
#pragma unroll
        for (int ai = 0; ai < 2; ++ai) {
            const int rl0 = ai * 128 + wr * 64 + fr; const size_t arow0 = (size_t)u.pm * 256 + rl0; const int cr0 = (u.pm & 7) * 256 + rl0;
            const int nc0 = wc * 32 + fq * 8;
            u32x4 uw[4][2];
#pragma unroll
            for (int m = 0; m < 4; ++m)
#pragma unroll
                for (int bj = 0; bj < 2; ++bj) uw[m][bj] = *(const u32x4*)(SSMA + (arow0 + m * 16) * 512 + bj * 128 + nc0);
#pragma unroll
            for (int m = 0; m < 4; ++m)
#pragma unroll
                for (int bj = 0; bj < 2; ++bj) asm volatile("" : "+v"(uw[m][bj]));
#pragma unroll
            for (int m = 0; m < 4; ++m)
#pragma unroll
                for (int bj = 0; bj < 2; ++bj) {
                    const int tau = (bj * 128 + nc0) >> 4; const u32x4 w = uw[m][bj];
                    f32x4 y0 = acc[ai][bj][m][0], y1 = acc[ai][bj][m][1];
                    y0[0] += d0[0] * bflo(w.x); y0[1] += d0[1] * bfhi(w.x); y0[2] += d0[2] * bflo(w.y); y0[3] += d0[3] * bfhi(w.y);
                    y1[0] += d1[0] * bflo(w.z); y1[1] += d1[1] * bfhi(w.z); y1[2] += d1[2] * bflo(w.w); y1[3] += d1[3] * bfhi(w.w);
#pragma unroll
                    for (int i = 0; i < 4; ++i) { y0[i] = gelu_tanh(y0[i]); y1[i] = gelu_tanh(y1[i]); }
                    *(u32x4*)(Z + ((size_t)(cr0 + m * 16) * 16 + tau) * 512 + g * 16 + 8 * (fq & 1)) = pack8(y0, y1);
                }
        }
    }
};
struct EpiMerge {
    static constexpr bool PERM = true;
    bf16_t* GA; bf16_t* GS; const float* bglu;
    __device__ __forceinline__ void operator()(const Acc& acc, const Unit& u, int wr, int wc, int fr, int fq) const {
        { const int ln = fresh_lane(); fr = ln & 15; fq = ln >> 4; }
        if (u.aux == 0) {
            const int yc0 = u.pn * 128 + wc * 32 + fq * 8;
            const f32x4 bl0 = *(const f32x4*)(bglu + yc0), bl1 = *(const f32x4*)(bglu + yc0 + 4), bg0 = *(const f32x4*)(bglu + 1024 + yc0), bg1 = *(const f32x4*)(bglu + 1024 + yc0 + 4);
            bf16_t* gp0 = GS + (size_t)(u.pm * 256 + wr * 64 + fr) * 1024 + yc0;
            u32x4 gw[2][4];
#pragma unroll
            for (int ai = 0; ai < 2; ++ai)
#pragma unroll
                for (int m = 0; m < 4; ++m) gw[ai][m] = *(const u32x4*)(gp0 + (size_t)(ai * 128 + m * 16) * 1024);
#pragma unroll
            for (int ai = 0; ai < 2; ++ai)
#pragma unroll
                for (int m = 0; m < 4; ++m) asm volatile("" : "+v"(gw[ai][m]));
#pragma unroll
            for (int ai = 0; ai < 2; ++ai)
#pragma unroll
                for (int m = 0; m < 4; ++m) {
                    const u32x4 g = gw[ai][m];
                    f32x4 s0, s1;
                    s0[0] = bflo(g.x); s0[1] = bfhi(g.x); s0[2] = bflo(g.y); s0[3] = bfhi(g.y); s1[0] = bflo(g.z); s1[1] = bfhi(g.z); s1[2] = bflo(g.w); s1[3] = bfhi(g.w);
                    f32x4 y0, y1;
#pragma unroll
                    for (int i = 0; i < 4; ++i) { y0[i] = s0[i] * (acc[ai][0][m][0][i] + bl0[i]) * sigmoidf_(acc[ai][1][m][0][i] + bg0[i]); y1[i] = s1[i] * (acc[ai][0][m][1][i] + bl1[i]) * sigmoidf_(acc[ai][1][m][1][i] + bg1[i]); }
                    *(u32x4*)(gp0 + (size_t)(ai * 128 + m * 16) * 1024) = pack8(y0, y1);
                }
        } else {
#pragma unroll
            for (int ai = 0; ai < 2; ++ai) {
                const size_t roff = (size_t)(u.pm * 256 + ai * 128 + wr * 64 + fr) * 1024 + u.pn * 256 + wc * 32 + fq * 8;
                u32x4 gw[4][2], tw[4][2];
#pragma unroll
                for (int m = 0; m < 4; ++m)
#pragma unroll
                    for (int bj = 0; bj < 2; ++bj) { gw[m][bj] = *(const u32x4*)(GA + roff + (size_t)m * 16 * 1024 + bj * 128); tw[m][bj] = *(const u32x4*)(GS + roff + (size_t)m * 16 * 1024 + bj * 128); }
#pragma unroll
                for (int m = 0; m < 4; ++m)
#pragma unroll
                    for (int bj = 0; bj < 2; ++bj) asm volatile("" : "+v"(gw[m][bj]), "+v"(tw[m][bj]));
#pragma unroll
                for (int m = 0; m < 4; ++m)
#pragma unroll
                    for (int bj = 0; bj < 2; ++bj) {
                        const u32x4 g = gw[m][bj], t = tw[m][bj];
                        const f32x4 a0 = acc[ai][bj][m][0], a1 = acc[ai][bj][m][1];
                        f32x4 o0, o1;
                        o0[0] = bflo(g.x) * a0[0] + bflo(t.x); o0[1] = bfhi(g.x) * a0[1] + bfhi(t.x); o0[2] = bflo(g.y) * a0[2] + bflo(t.y); o0[3] = bfhi(g.y) * a0[3] + bfhi(t.y);
                        o1[0] = bflo(g.z) * a1[0] + bflo(t.z); o1[1] = bfhi(g.z) * a1[1] + bfhi(t.z); o1[2] = bflo(g.w) * a1[2] + bflo(t.w); o1[3] = bfhi(g.w) * a1[3] + bfhi(t.w);
                        *(u32x4*)(GA + roff + (size_t)m * 16 * 1024 + bj * 128) = pack8(o0, o1);
                    }
            }
        }
    }
};

namespace att {
constexpr int QBLK = 32, KVBLK = 64, LDX = 512;
constexpr int NSLOT = 4, SHM_V = 16384, SHM_K = 8192, OFF_K = NSLOT * SHM_V, OFF_WS = NSLOT * (SHM_V + SHM_K);
constexpr float SCALE = 0.125f, THR = 8.f;
#define KSWZ(row, colB) ((row) * 128 + ((colB) ^ ((((row) >> 1) & 7) << 4)))
#define SBAR() __builtin_amdgcn_sched_barrier(0)
__device__ __forceinline__ int crow(int r, int hi) { return (r & 3) + 8 * (r >> 2) + 4 * hi; }
__device__ __forceinline__ void partialSM(f32x16& p0, f32x16& p1, float& mhat, f32x16& negm, float& alpha, const bool first) {
    constexpr float THRL = THR * 1.4426950408889634f;
    float pmax = p0[0];
#pragma unroll
    for (int r = 1; r < 16; ++r) pmax = fmaxf(pmax, p0[r]);
#pragma unroll
    for (int r = 0; r < 16; ++r) pmax = fmaxf(pmax, p1[r]);
    { auto rr = __builtin_amdgcn_permlane32_swap(__float_as_uint(pmax), __float_as_uint(pmax), false, false);
      pmax = fmaxf(__uint_as_float(rr[0]), __uint_as_float(rr[1])); }
    if (__builtin_expect(!first && __all(pmax <= THRL), 1)) { alpha = 1.f; }
    else { const float dl = first ? pmax : fmaxf(pmax, 0.f); mhat += dl; alpha = first ? 0.f : __builtin_amdgcn_exp2f(-dl);
#pragma unroll
        for (int r = 0; r < 16; ++r) { p0[r] -= dl; p1[r] -= dl; }
#pragma unroll
        for (int r = 0; r < 16; ++r) negm[r] = -mhat; }
#pragma unroll
    for (int r = 0; r < 16; ++r) p0[r] = __builtin_amdgcn_exp2f(p0[r]);
}
__device__ __forceinline__ void finishSM(f32x16& p0, f32x16& p1, float alpha, float& l_reg, bf16x8& pa0, bf16x8& pa1, bf16x8& pa2, bf16x8& pa3) {
#pragma unroll
    for (int r = 0; r < 16; ++r) p1[r] = __builtin_amdgcn_exp2f(p1[r]);
    float ps = 0;
#pragma unroll
    for (int r = 0; r < 16; ++r) ps += p0[r];
#pragma unroll
    for (int r = 0; r < 16; ++r) ps += p1[r];
    { auto rr = __builtin_amdgcn_permlane32_swap(__float_as_uint(ps), __float_as_uint(ps), false, false);
      ps = __uint_as_float(rr[0]) + __uint_as_float(rr[1]); }
    l_reg = l_reg * alpha + ps;
#define PK4(P, BASE, OUT) do { unsigned a0 = cvt_pk_bf16(P[BASE + 0], P[BASE + 1]), a1 = cvt_pk_bf16(P[BASE + 2], P[BASE + 3]);   \
    unsigned b0 = cvt_pk_bf16(P[BASE + 4], P[BASE + 5]), b1 = cvt_pk_bf16(P[BASE + 6], P[BASE + 7]);                              \
    auto r0 = __builtin_amdgcn_permlane32_swap(a0, b0, false, false); auto r1 = __builtin_amdgcn_permlane32_swap(a1, b1, false, false); \
    u32x4 w = {r0[0], r1[0], r0[1], r1[1]}; OUT = __builtin_bit_cast(bf16x8, w); } while (0)
    PK4(p0, 0, pa0); PK4(p0, 8, pa1); PK4(p1, 0, pa2); PK4(p1, 8, pa3);
#undef PK4
}
__device__ __forceinline__ void qkt(f32x16& p0, f32x16& p1, const LAS char* Ks, const bf16x8* qr, const f32x16& negm, int r32, int hi) {
#pragma unroll
    for (int d0 = 0; d0 < 4; ++d0) { const int cb = (d0 * 16 + hi * 8) * 2;
        const bf16x8 b0 = *(const LAS bf16x8*)(Ks + KSWZ(r32, cb));
        const bf16x8 b1 = *(const LAS bf16x8*)(Ks + KSWZ(32 + r32, cb));
        if (d0 == 0) { p0 = __builtin_amdgcn_mfma_f32_32x32x16_bf16(b0, qr[0], negm, 0, 0, 0); p1 = __builtin_amdgcn_mfma_f32_32x32x16_bf16(b1, qr[0], negm, 0, 0, 0); }
        else { p0 = __builtin_amdgcn_mfma_f32_32x32x16_bf16(b0, qr[d0], p0, 0, 0, 0); p1 = __builtin_amdgcn_mfma_f32_32x32x16_bf16(b1, qr[d0], p1, 0, 0, 0); } }
}
__device__ __forceinline__ int v_st(int k, int c) { const int kk = (k & ~0xC) | ((k & 4) << 1) | ((k & 8) >> 1); return ((kk >> 3) * 4 + (c >> 5)) * 512 + ((kk & 7) * 32 + (c & 31)) * 2; }
__device__ __forceinline__ int v_rd_base(int lane) { return ((lane & 3) << 3) | (((lane >> 2) & 3) << 6) | (((lane >> 4) & 1) << 5) | (((lane >> 5) & 1) << 8); }
constexpr int v_rd_off(int d0, int ks, int half) { return d0 * 512 + ks * 4096 + half * 2048; }
template <int OFF> __device__ __forceinline__ s16x4 tr_read(int vb) {
    s16x4 r; asm volatile("ds_read_b64_tr_b16 %0, %1 offset:%2" : "=&v"(r) : "v"(vb), "i"(OFF) : "memory"); return r;
}
template <int D0> __device__ __forceinline__ void pv_one(f32x16& od, int vb, bf16x8 pa0, bf16x8 pa1, bf16x8 pa2, bf16x8 pa3) {
    const s16x4 l0 = tr_read<v_rd_off(D0, 0, 0)>(vb), h0 = tr_read<v_rd_off(D0, 0, 1)>(vb), l1 = tr_read<v_rd_off(D0, 1, 0)>(vb), h1 = tr_read<v_rd_off(D0, 1, 1)>(vb);
    const s16x4 l2 = tr_read<v_rd_off(D0, 2, 0)>(vb), h2 = tr_read<v_rd_off(D0, 2, 1)>(vb), l3 = tr_read<v_rd_off(D0, 3, 0)>(vb), h3 = tr_read<v_rd_off(D0, 3, 1)>(vb);
    asm volatile("s_waitcnt lgkmcnt(0)" ::: "memory"); SBAR();
#define PK(L, H) (bf16x8){L[0], L[1], L[2], L[3], H[0], H[1], H[2], H[3]}
    od = __builtin_amdgcn_mfma_f32_32x32x16_bf16(pa0, PK(l0, h0), od, 0, 0, 0);
    od = __builtin_amdgcn_mfma_f32_32x32x16_bf16(pa1, PK(l1, h1), od, 0, 0, 0);
    od = __builtin_amdgcn_mfma_f32_32x32x16_bf16(pa2, PK(l2, h2), od, 0, 0, 0);
    od = __builtin_amdgcn_mfma_f32_32x32x16_bf16(pa3, PK(l3, h3), od, 0, 0, 0);
#undef PK
}
__device__ __forceinline__ void pv_d0(f32x16* o, int vb, bf16x8 pa0, bf16x8 pa1, bf16x8 pa2, bf16x8 pa3) {
    pv_one<0>(o[0], vb, pa0, pa1, pa2, pa3); pv_one<1>(o[1], vb, pa0, pa1, pa2, pa3); pv_one<2>(o[2], vb, pa0, pa1, pa2, pa3); pv_one<3>(o[3], vb, pa0, pa1, pa2, pa3);
}
__device__ __forceinline__ void attn_pass(const bf16_t* __restrict__ Qb, const bf16_t* __restrict__ Kh, const bf16_t* __restrict__ Vh, int seq, LAS char* lds, const int wid, f32x16 (&o)[4], float (&rli)[16]) {
    const int lane = fresh_lane(), tid = wid * 64 + lane, r32 = lane & 31, hi = lane >> 5;
    LAS char* V_lds = lds; LAS char* K_lds = lds + OFF_K;
    LAS float* ws = (LAS float*)(lds + OFF_WS) + wid * 64; LAS float* li_l = ws; LAS float* al_l = ws + 32;
    float mhat = 0.f, l_reg = 0; f32x16 negm = f32x16{};
#pragma unroll
    for (int d = 0; d < 4; ++d) o[d] = f32x16{};
    bf16x8 qr[4];
    const bf16_t* Qw = Qb + (size_t)(wid * QBLK + r32) * LDX + hi * 8;
#pragma unroll
    for (int d0 = 0; d0 < 4; ++d0) qr[d0] = *(const bf16x8*)(Qw + d0 * 16);
    const int sr = tid >> 4, sc = (tid & 15) * 8, vst0 = v_st(sr, sc), vst1 = v_st(32 + sr, sc);
    const int kr = tid >> 3, kc = (tid & 7) * 8, kst = KSWZ(kr, kc * 2);
    const int vb0 = (int)(unsigned)(uintptr_t)V_lds + v_rd_base(lane);
    struct { bf16x8 vs0, vs1, ks0; } sr_[2];
#define SLOAD(i, k0) do { sr_[i].vs0 = *(const bf16x8*)(&Vh[(size_t)((k0) + sr) * LDX + sc]); sr_[i].vs1 = *(const bf16x8*)(&Vh[(size_t)((k0) + 32 + sr) * LDX + sc]); \
    sr_[i].ks0 = *(const bf16x8*)(&Kh[(size_t)((k0) + kr) * LDX + kc]); } while (0)
#define SWRITE(b, i) do { *(LAS bf16x8*)(V_lds + (b) * SHM_V + vst0) = sr_[i].vs0; *(LAS bf16x8*)(V_lds + (b) * SHM_V + vst1) = sr_[i].vs1; \
    *(LAS bf16x8*)(K_lds + (b) * SHM_K + kst) = sr_[i].ks0; } while (0)
#define SWAIT() asm volatile("s_waitcnt vmcnt(3)" ::: "memory")
#define RESC(a) do { if (__any((a) < 1.f)) { if (hi == 0) al_l[r32] = (a); asm volatile("s_waitcnt lgkmcnt(0)" ::: "memory"); \
    _Pragma("unroll") for (int d = 0; d < 4; ++d) _Pragma("unroll") for (int r = 0; r < 16; ++r) o[d][r] *= al_l[crow(r, hi)]; } } while (0)
    f32x16 pA0, pA1; float alA; bf16x8 pa0, pa1, pa2, pa3; const int NT = seq / KVBLK;
#define WBAR() asm volatile("s_waitcnt lgkmcnt(0)\n\ts_barrier" ::: "memory")
    const bool lag = wid >= 4;
    SLOAD(0, 0); asm volatile("s_waitcnt vmcnt(0)" ::: "memory"); SWRITE(0, 0);
    SLOAD(1, KVBLK); SLOAD(0, 2 * KVBLK);
    __syncthreads();
    qkt(pA0, pA1, K_lds, qr, negm, r32, hi);
    partialSM(pA0, pA1, mhat, negm, alA, true); finishSM(pA0, pA1, alA, l_reg, pa0, pa1, pa2, pa3);
    SWAIT(); SWRITE(1, 1);
    SLOAD(1, 3 * KVBLK);
    SWAIT(); SWRITE(2, 0);
    __syncthreads();
    if (lag) WBAR();
    for (int j = 1; j + 1 < NT; j += 2) {
        SBAR(); __builtin_amdgcn_s_setprio(1); qkt(pA0, pA1, K_lds + (j & 3) * SHM_K, qr, negm, r32, hi); pv_d0(o, vb0 + ((j - 1) & 3) * SHM_V, pa0, pa1, pa2, pa3); __builtin_amdgcn_s_setprio(0); SBAR();
        WBAR();
        SWRITE((j + 2) & 3, 1);
        if (j + 3 < NT) SLOAD(0, (j + 3) * KVBLK);
        partialSM(pA0, pA1, mhat, negm, alA, false); RESC(alA); finishSM(pA0, pA1, alA, l_reg, pa0, pa1, pa2, pa3);
        WBAR();
        SBAR(); __builtin_amdgcn_s_setprio(1); qkt(pA0, pA1, K_lds + ((j + 1) & 3) * SHM_K, qr, negm, r32, hi); pv_d0(o, vb0 + (j & 3) * SHM_V, pa0, pa1, pa2, pa3); __builtin_amdgcn_s_setprio(0); SBAR();
        WBAR();
        if (j + 3 < NT) SWRITE((j + 3) & 3, 0);
        if (j + 4 < NT) SLOAD(1, (j + 4) * KVBLK);
        partialSM(pA0, pA1, mhat, negm, alA, false); RESC(alA); finishSM(pA0, pA1, alA, l_reg, pa0, pa1, pa2, pa3);
        WBAR();
    }
    SBAR(); __builtin_amdgcn_s_setprio(1); qkt(pA0, pA1, K_lds + ((NT - 1) & 3) * SHM_K, qr, negm, r32, hi); pv_d0(o, vb0 + ((NT - 2) & 3) * SHM_V, pa0, pa1, pa2, pa3); __builtin_amdgcn_s_setprio(0); SBAR();
    WBAR();
    partialSM(pA0, pA1, mhat, negm, alA, false); RESC(alA); finishSM(pA0, pA1, alA, l_reg, pa0, pa1, pa2, pa3);
    WBAR();
    SBAR(); pv_d0(o, vb0 + ((NT - 1) & 3) * SHM_V, pa0, pa1, pa2, pa3);
    if (!lag) WBAR();
#undef WBAR
    if (hi == 0) li_l[r32] = l_reg; asm volatile("s_waitcnt lgkmcnt(0)" ::: "memory");
#pragma unroll
    for (int r = 0; r < 16; ++r) rli[r] = __builtin_amdgcn_rcpf(li_l[crow(r, hi)]);
    asm volatile("s_waitcnt vmcnt(0) lgkmcnt(0)" ::: "memory");
    __syncthreads();
#undef SLOAD
#undef SWRITE
#undef SWAIT
#undef RESC
}
}

#define WSP(T, off) ((T*)(fresh_ptr(ws) + (off)))
#define MOD WSP(float, WS_MOD)
#define ROPE WSP(float, WS_ROPE)
#define A16 WSP(float, WS_A16)
#define WIN WSP(bf16_t, WS_WIN)
#define WATT WSP(bf16_t, WS_WATT)
#define WGLU WSP(bf16_t, WS_WGLU)
#define WO WSP(bf16_t, WS_WO)
#define WFI WSP(bf16_t, WS_WFI)
#define WFO WSP(bf16_t, WS_WFO)
#define BTS WSP(bf16_t, WS_BTS)
#define BTY WSP(bf16_t, WS_BTY)
#define Hb WSP(bf16_t, WS_H)
#define Sb WSP(float, WS_H)
#define Zb WSP(bf16_t, WS_H)
#define Qb WSP(bf16_t, WS_Q)
#define Kb WSP(bf16_t, WS_K)
#define Vb WSP(bf16_t, WS_V)
#define SSMA WSP(bf16_t, WS_SSMA)
#define GA WSP(bf16_t, WS_GA)
#define GS WSP(bf16_t, WS_GS)
#define ACT WSP(bf16_t, WS_ACT)
#define STASH (WSP(float, WS_STASH) + (size_t)bx * 65536)

__device__ __forceinline__ int dstrow(int mode, int n) {
    if (mode == 1) { if (n < 1024) { const int d = n & 63; return (n & ~63) + ((d & 31) << 1) + (d >> 5); } return n; }
    if (mode == 2) { const int c = n < 1024 ? n : n - 1024; return 256 * (c >> 7) + (n < 1024 ? 0 : 128) + (c & 127); }
    if (mode == 3) { const int c = n < DFF ? n : n - DFF; return 256 * (c >> 7) + (n < DFF ? 0 : 128) + (c & 127); }
    return n;
}
__device__ __forceinline__ void transpose_item(const float* __restrict__ W, int K, int N, bf16_t* __restrict__ WT, int mode, LAS float* scr, int item, int lane) {
    const int nblk = N / 32, kb = item / nblk, nb = item % nblk, k0 = 64 * kb, n0 = 32 * nb;
#pragma unroll 8
    for (int i = 0; i < 32; ++i) { const int kk = 2 * i + (lane >> 5); scr[kk * 33 + (lane & 31)] = W[(size_t)(k0 + kk) * N + n0 + (lane & 31)]; }
    asm volatile("s_waitcnt lgkmcnt(0)" ::: "memory");
    const int c = lane & 7;
#pragma unroll
    for (int j = 0; j < 4; ++j) { const int n = (lane >> 3) + 8 * j; const LAS float* s = scr + (8 * c) * 33 + n;
        u32x4 o; o.x = cvt_pk_bf16(s[0 * 33], s[1 * 33]); o.y = cvt_pk_bf16(s[2 * 33], s[3 * 33]); o.z = cvt_pk_bf16(s[4 * 33], s[5 * 33]); o.w = cvt_pk_bf16(s[6 * 33], s[7 * 33]);
        *(u32x4*)(WT + (size_t)dstrow(mode, n0 + n) * K + k0 + 8 * c) = o; }
    asm volatile("s_waitcnt lgkmcnt(0)" ::: "memory");
}

__device__ __forceinline__ void convert_job(const Args& a, unsigned char* ws, int l, int mask, LAS unsigned char* lds, int wave, int cw, int ncw) {
    const int lane = fresh_lane();
    LAS float* scr = (LAS float*)(lds + wave * 16384);
    constexpr int I_IN = 16 * 128, I_AT = 8 * 32, I_GL = 8 * 64, I_WO = 16 * 32, I_FI = 16 * 176, I_FO = 44 * 32;
    if (mask & 1) for (int r = cw; r < I_IN; r += ncw) transpose_item(a.in[7] + (size_t)l * 1024 * 4096, 1024, 4096, WIN, 1, scr, r, lane);
    if (mask & 2) for (int it = cw; it < I_AT + I_GL + I_WO; it += ncw) { int r = it;
        if (r < I_AT) { transpose_item(a.in[13] + (size_t)l * 512 * 1024, 512, 1024, WATT, 0, scr, r, lane); continue; } r -= I_AT;
        if (r < I_GL) { transpose_item(a.in[22] + (size_t)l * 512 * 2048, 512, 2048, WGLU, 2, scr, r, lane); continue; } r -= I_GL;
        transpose_item(a.in[24] + (size_t)l * 1024 * 1024, 1024, 1024, WO, 0, scr, r, lane); }
    if (mask & 4) for (int it = cw; it < I_FI + I_FO; it += ncw) { int r = it;
        if (r < I_FI) { transpose_item(a.in[26] + (size_t)l * 1024 * 5632, 1024, 5632, WFI, 3, scr, r, lane); continue; } r -= I_FI;
        transpose_item(a.in[27] + (size_t)l * 2816 * 1024, 2816, 1024, WFO, 0, scr, r, lane); }
}

__device__ __forceinline__ void ssm_gen(const Args& a, int l, int g, LAS float* L, bf16_t* bts_, bf16_t* bty_, float* a16_, int wave) {
    const int tid = fresh_tid(wave);
    LAS float* Ap = L; LAS float* Bb = L + 4352; LAS float* Cc = Bb + 4096; LAS float* Kt = Cc + 4096;
    const float* a_re = a.in[14]; const float* a_im = a.in[15]; const float* log_dt = a.in[16];
    const float* b_re = a.in[17]; const float* b_im = a.in[18]; const float* c_re = a.in[19]; const float* c_im = a.in[20];
    if (tid < 128) {
        const int dir = tid >> 6, p = tid & 63; const int gi = (l * 2 + dir) * 32 + g;
        const float dt = expf(log_dt[gi]), ar = a_re[gi * 64 + p], ai = a_im[gi * 64 + p];
        const float mag = expf(dt * ar), abr = mag * cosf(dt * ai), abi = mag * sinf(dt * ai);
        const float nr = abr - 1.0f, ni = abi, den = ar * ar + ai * ai;
        const float fr = (nr * ar + ni * ai) / den, fi = (ni * ar - nr * ai) / den;
        float pr = 1.f, pi = 0.f; asm volatile("" : "+v"(pr), "+v"(pi));
        for (int j = 0; j <= 16; ++j) { Ap[((dir * 17 + j) * 64 + p) * 2] = pr; Ap[((dir * 17 + j) * 64 + p) * 2 + 1] = pi; const float t = pr * abr - pi * abi; pi = pr * abi + pi * abr; pr = t; }
        a16_[((g * 2 + dir) * 64 + p) * 2] = Ap[((dir * 17 + 16) * 64 + p) * 2]; a16_[((g * 2 + dir) * 64 + p) * 2 + 1] = Ap[((dir * 17 + 16) * 64 + p) * 2 + 1];
        for (int c = 0; c < 16; ++c) { const float br = b_re[((size_t)gi * 64 + p) * 16 + c], bi = b_im[((size_t)gi * 64 + p) * 16 + c];
            Bb[((dir * 64 + p) * 16 + c) * 2] = fr * br - fi * bi; Bb[((dir * 64 + p) * 16 + c) * 2 + 1] = fr * bi + fi * br; }
    }
    for (int i = tid; i < 2048; i += NTHREADS) { const int dir = i >> 10, cp = i & 1023; const int gi = (l * 2 + dir) * 32 + g;
        Cc[i * 2] = c_re[(size_t)gi * 1024 + cp]; Cc[i * 2 + 1] = c_im[(size_t)gi * 1024 + cp]; }
    __syncthreads();
    for (int idx = tid; idx < 8192; idx += NTHREADS) {
        const int cp = idx & 15, c = (idx >> 4) & 15, j = (idx >> 8) & 15, dir = idx >> 12; float s = 0.f;
        for (int p = 0; p < 64; ++p) {
            const float cr = Cc[((dir * 16 + c) * 64 + p) * 2], ci = Cc[((dir * 16 + c) * 64 + p) * 2 + 1];
            const float pr = Ap[((dir * 17 + j) * 64 + p) * 2], pi = Ap[((dir * 17 + j) * 64 + p) * 2 + 1];
            const float br = Bb[((dir * 64 + p) * 16 + cp) * 2], bi = Bb[((dir * 64 + p) * 16 + cp) * 2 + 1];
            const float car = cr * pr - ci * pi, cai = cr * pi + ci * pr;
            s += car * br - cai * bi;
        }
        Kt[idx] = s;
    }
    __syncthreads();
    for (int ch = tid; ch < 256 * 32; ch += NTHREADS) {
        const int n = ch >> 5, k0 = (ch & 31) * 8; const int dir = n >> 7, ri = (n >> 6) & 1, p = n & 63; float v[8];
#pragma unroll
        for (int e = 0; e < 8; ++e) { const int k = k0 + e, sg = k >> 4, c = k & 15, ex = dir ? sg : 15 - sg;
            const float pr = Ap[((dir * 17 + ex) * 64 + p) * 2], pi = Ap[((dir * 17 + ex) * 64 + p) * 2 + 1], br = Bb[((dir * 64 + p) * 16 + c) * 2], bi = Bb[((dir * 64 + p) * 16 + c) * 2 + 1];
            v[e] = ri ? (pr * bi + pi * br) : (pr * br - pi * bi); }
        u32x4 w; w.x = cvt_pk_bf16(v[0], v[1]); w.y = cvt_pk_bf16(v[2], v[3]); w.z = cvt_pk_bf16(v[4], v[5]); w.w = cvt_pk_bf16(v[6], v[7]);
        *(u32x4*)(bts_ + ((size_t)g * 256 + n) * 256 + k0) = w;
    }
    for (int ch = tid; ch < 256 * 64; ch += NTHREADS) {
        const int n = ch >> 6, k0 = (ch & 63) * 8; const int tau = n >> 4, c = n & 15; float v[8];
#pragma unroll
        for (int e = 0; e < 8; ++e) { const int k = k0 + e; float x;
            if (k < 256) { const int sg = k >> 4, cp = k & 15; x = 0.f;
                if (sg <= tau) x += Kt[((0 * 16 + (tau - sg)) * 16 + c) * 16 + cp];
                if (sg >= tau) x += Kt[((1 * 16 + (sg - tau)) * 16 + c) * 16 + cp];
            } else { const int kk = k - 256, dir = kk >> 7, ri = (kk >> 6) & 1, p = kk & 63, ex = dir ? 16 - tau : tau + 1;
                const float cr = Cc[((dir * 16 + c) * 64 + p) * 2], ci = Cc[((dir * 16 + c) * 64 + p) * 2 + 1], pr = Ap[((dir * 17 + ex) * 64 + p) * 2], pi = Ap[((dir * 17 + ex) * 64 + p) * 2 + 1];
                x = ri ? -(cr * pi + ci * pr) : (cr * pr - ci * pi); }
            v[e] = x; }
        u32x4 w; w.x = cvt_pk_bf16(v[0], v[1]); w.y = cvt_pk_bf16(v[2], v[3]); w.z = cvt_pk_bf16(v[4], v[5]); w.w = cvt_pk_bf16(v[6], v[7]);
        *(u32x4*)(bty_ + ((size_t)g * 256 + n) * 512 + k0) = w;
    }
    __syncthreads();
}

__device__ __forceinline__ void norm_rows(const float* __restrict__ x, bf16_t* __restrict__ H, const float* __restrict__ gam, const float* __restrict__ modl  ,
                                          int sh_off, int sc_off, int Lshift, int gw, int NGW, int lane_in) {
    const int lane = fresh_lane(); (void)lane_in;
    const int nb = MG >> Lshift, wpb = NGW / nb;
    if (wpb * nb == NGW && ((1 << Lshift) % (4 * wpb)) == 0) {
        const int b = gw / wpb, r0 = gw % wpb, L = 1 << Lshift;
        const float* mb = modl + (size_t)b * 6144;
        f32x4 gm[4], sh[4];
#pragma unroll
        for (int j = 0; j < 4; ++j) { const f32x4 g4 = *(const f32x4*)(gam + 4 * lane + 256 * j), sc = *(const f32x4*)(mb + sc_off + 4 * lane + 256 * j);
            gm[j] = g4 * (sc + 1.0f); sh[j] = *(const f32x4*)(mb + sh_off + 4 * lane + 256 * j); }
        const float* xb = x + (size_t)b * L * D; bf16_t* hb = H + (size_t)b * L * D;
        for (int r = r0; r < L; r += 4 * wpb) {
            f32x4 v[4][4]; float s[4];
#pragma unroll
            for (int q = 0; q < 4; ++q) { const f32x4* xr = (const f32x4*)(xb + (size_t)(r + q * wpb) * D) + lane;
#pragma unroll
                for (int j = 0; j < 4; ++j) v[q][j] = __builtin_nontemporal_load(&xr[64 * j]); }
#pragma unroll
            for (int q = 0; q < 4; ++q) { float t = 0.f;
#pragma unroll
                for (int j = 0; j < 4; ++j) t += (v[q][j].x * v[q][j].x + v[q][j].y * v[q][j].y) + (v[q][j].z * v[q][j].z + v[q][j].w * v[q][j].w);
                s[q] = rsqrtf(wave_sum(t) * (1.f / D) + EPS); }
#pragma unroll
            for (int q = 0; q < 4; ++q) {
                u32x2* o = (u32x2*)(hb + (size_t)(r + q * wpb) * D) + lane;
#pragma unroll
                for (int j = 0; j < 4; ++j) { const f32x4 h = v[q][j] * s[q] * gm[j] + sh[j];
                    u32x2 w; w.x = cvt_pk_bf16(h[0], h[1]); w.y = cvt_pk_bf16(h[2], h[3]); o[64 * j] = w; }
            }
        }
        return;
    }
    f32x4 gv[4];
#pragma unroll
    for (int j = 0; j < 4; ++j) gv[j] = *(const f32x4*)(gam + 4 * lane + 256 * j);
    for (int row = gw; row < MG; row += NGW) {
        const f32x4* xr = (const f32x4*)(x + (size_t)row * D) + lane;
        f32x4 v[4]; float s = 0.f;
#pragma unroll
        for (int j = 0; j < 4; ++j) { v[j] = xr[64 * j]; s += (v[j].x * v[j].x + v[j].y * v[j].y) + (v[j].z * v[j].z + v[j].w * v[j].w); }
        const float r = rsqrtf(wave_sum(s) * (1.f / D) + EPS);
        const float* mb = modl + (size_t)(row >> Lshift) * 6144;
        u32x2* o = (u32x2*)(H + (size_t)row * D) + lane;
#pragma unroll
        for (int j = 0; j < 4; ++j) {
            const f32x4 sc = *(const f32x4*)(mb + sc_off + 4 * lane + 256 * j), sh = *(const f32x4*)(mb + sh_off + 4 * lane + 256 * j);
            const f32x4 h = v[j] * r * gv[j] * (sc + 1.0f) + sh;
            u32x2 w; w.x = cvt_pk_bf16(h[0], h[1]); w.y = cvt_pk_bf16(h[2], h[3]); o[64 * j] = w;
        }
    }
}

#define XB_TMO      128
#define XB_XCNT(j)  (256  + 64 * (j))
#define XB_XSUB(j)  (1280 + 64 * (j))
#define XB_XGEN(j)  (2304 + 64 * (j))
#define XB_TOP      3328
#define XB_TOPGEN   3392
#define XCD_BAR_WORDS 3456
#define XB_SPIN_CAP (1u << 18)
__device__ __forceinline__ unsigned xb_ld(unsigned* p)              { return __hip_atomic_load(p, __ATOMIC_RELAXED, __HIP_MEMORY_SCOPE_AGENT); }
__device__ __forceinline__ unsigned xb_add(unsigned* p, unsigned v) { return __hip_atomic_fetch_add(p, v, __ATOMIC_RELAXED, __HIP_MEMORY_SCOPE_AGENT); }
__device__ __forceinline__ unsigned xb_xcc_id() { return (unsigned)__builtin_amdgcn_s_getreg((3 << 11) | 20) & 0xFu; }
#define XB_SPIN(cond, bar) do { unsigned _sp = 0; while (cond) { __builtin_amdgcn_s_sleep(1); \
    if ((++_sp & 255u) == 0u) { if (xb_ld(&(bar)[XB_TMO])) break; if (_sp > XB_SPIN_CAP) { atomicAdd(&(bar)[XB_TMO], 1u); break; } } } } while (0)
struct XcdBarrier { unsigned* bar; unsigned x; volatile LAS unsigned* st; };
__device__ __forceinline__ XcdBarrier xcd_barrier_post(unsigned* bar, volatile LAS unsigned* st) {
    XcdBarrier b; b.bar = bar; b.x = xb_xcc_id(); b.st = st;
    if (threadIdx.x == 0) (void)xb_add(&bar[XB_XCNT(b.x)], 1u);
    return b;
}
__device__ __forceinline__ void xcd_barrier_complete(unsigned* bar, unsigned x, unsigned& nloc, unsigned& nx) {
    const unsigned G = gridDim.x * gridDim.y * gridDim.z;
    unsigned sum, cnt, mine, sp = 0u;
    for (;;) {
        sum = 0u; cnt = 0u; mine = 0u;
#pragma unroll
        for (unsigned j = 0; j < 16; ++j) { const unsigned c = xb_ld(&bar[XB_XCNT(j)]); sum += c; cnt += (c > 0u) ? 1u : 0u; mine = (j == x) ? c : mine; }
        if (sum == G) break;
        __builtin_amdgcn_s_sleep(1);
        if ((++sp & 255u) == 0u) { if (xb_ld(&bar[XB_TMO])) break; if (sp > XB_SPIN_CAP) { atomicAdd(&bar[XB_TMO], 1u); break; } }
    }
    nloc = mine > 0u ? mine : 1u; nx = cnt > 0u ? cnt : 1u;
}
__device__ __forceinline__ void xcd_barrier(const XcdBarrier& b) {
    asm volatile("s_waitcnt vmcnt(0)" ::: "memory");
    __syncthreads();
    if (threadIdx.x == 0) {
        unsigned* bar = b.bar;
        __builtin_amdgcn_s_waitcnt(0);
        unsigned nloc = b.st[0], nx = b.st[1];
        if (nloc == 0u) { xcd_barrier_complete(bar, b.x, nloc, nx); b.st[0] = nloc; b.st[1] = nx; }
        const unsigned old = xb_add(&bar[XB_XSUB(b.x)], 1u);
        const unsigned gen = old / nloc;
        if (old + 1u == (gen + 1u) * nloc) {
            __builtin_amdgcn_fence(__ATOMIC_RELEASE, "agent");
            asm volatile("s_waitcnt vmcnt(0)" ::: "memory");
            const unsigned og = xb_add(&bar[XB_TOP], 1u);
            const unsigned tg = og / nx;
            if (og + 1u == (tg + 1u) * nx) xb_add(&bar[XB_TOPGEN], 1u);
            else XB_SPIN(xb_ld(&bar[XB_TOPGEN]) == tg, bar);
            __builtin_amdgcn_fence(__ATOMIC_ACQUIRE, "agent");
            xb_add(&bar[XB_XGEN(b.x)], 1u);
            asm volatile("s_waitcnt vmcnt(0)" ::: "memory");
        } else {
            XB_SPIN(xb_ld(&bar[XB_XGEN(b.x)]) == gen, bar);
            __builtin_amdgcn_fence(__ATOMIC_ACQUIRE, "agent");
            asm volatile("s_waitcnt vmcnt(0)" ::: "memory");
        }
    }
    __syncthreads();
}

__global__ void __launch_bounds__(NTHREADS, 2) mega(Args a) {
    extern __shared__ __attribute__((aligned(16))) unsigned char lds_raw[];
    LAS unsigned char* lds = (LAS unsigned char*)lds_raw;
    cg::grid_group grid = cg::this_grid();
    const int wave = __builtin_amdgcn_readfirstlane((int)threadIdx.x >> 6);
    const int G = gridDim.x, bx = blockIdx.x;
    const int vcu = (G % 8 == 0) ? (bx % 8) * (G / 8) + bx / 8 : bx;
    const int gw = bx * NWAVES + wave, NGW = G * NWAVES;
    unsigned char* ws = a.ws;
    {
        if (bx == 0) for (int i = threadIdx.x; i < XCD_BAR_WORDS; i += NTHREADS) ((unsigned*)(ws + WS_BAR))[i] = 0u;
        if (threadIdx.x < 2) ((volatile LAS unsigned*)(lds + LDS_MISC))[threadIdx.x] = 0u;
        __syncthreads();
    }

#ifndef NO_P0
    {
        const int tid = fresh_tid(wave);
        LAS float* scv = (LAS float*)lds;
        LAS float* red = (LAS float*)(lds + 49152);
        for (int item = bx; item < 192; item += G) {
            const int l = item / 48, nb = item % 48, c = tid & 127, kq = tid >> 7, n = nb * 128 + c;
            __syncthreads();
            for (int i = tid; i < 12 * 1024; i += NTHREADS) { const int b = i >> 10, k = i & 1023; const float cv = b < 8 ? a.in[2][b * 1024 + k] : a.in[3][(b - 8) * 1024 + k]; scv[k * 12 + b] = siluf_(cv); }
            __syncthreads();
            float acc[12];
#pragma unroll
            for (int b = 0; b < 12; ++b) acc[b] = 0.f;
            const float* wp = a.in[4] + (size_t)l * 1024 * 6144 + (size_t)(kq * 256) * 6144 + n;
            const LAS float* sp = scv + kq * 256 * 12;
#pragma unroll 8
            for (int k = 0; k < 256; ++k) {
                const float w = wp[(size_t)k * 6144];
                const f32x4 s0 = *(const LAS f32x4*)(sp + k * 12), s1 = *(const LAS f32x4*)(sp + k * 12 + 4), s2 = *(const LAS f32x4*)(sp + k * 12 + 8);
                acc[0] += s0[0] * w; acc[1] += s0[1] * w; acc[2] += s0[2] * w; acc[3] += s0[3] * w;
                acc[4] += s1[0] * w; acc[5] += s1[1] * w; acc[6] += s1[2] * w; acc[7] += s1[3] * w;
                acc[8] += s2[0] * w; acc[9] += s2[1] * w; acc[10] += s2[2] * w; acc[11] += s2[3] * w;
            }
#pragma unroll
            for (int b = 0; b < 12; ++b) red[(kq * 12 + b) * 128 + c] = acc[b];
            __syncthreads();
            for (int i = tid; i < 12 * 128; i += NTHREADS) { const int b = i >> 7, cc = i & 127;
                const float v = ((red[(0 * 12 + b) * 128 + cc] + red[(1 * 12 + b) * 128 + cc]) + red[(2 * 12 + b) * 128 + cc]) + red[(3 * 12 + b) * 128 + cc];
                MOD[((size_t)l * 12 + b) * 6144 + nb * 128 + cc] = v + a.in[5][l * 6144 + nb * 128 + cc]; }
        }
        for (int i = bx * NTHREADS + tid; i < 8192 * 32; i += G * NTHREADS) {
            const int pos = i >> 5, fi = i & 31; const float inv = 1.0f / powf(10000.0f, (float)fi * (1.0f / 32.0f)); const float ang = (float)pos * inv;
            ROPE[(size_t)i * 2] = cosf(ang); ROPE[(size_t)i * 2 + 1] = sinf(ang);
        }
    }
#endif
    grid.sync();
    const XcdBarrier xbar = xcd_barrier_post((unsigned*)(ws + WS_BAR), (volatile LAS unsigned*)(lds + LDS_MISC));

    for (int l = 0; l < DEPTH; ++l) {
        for (int grp = 0; grp < 2; ++grp) {
            float* xg = a.out + (size_t)grp * MG * D;
            const int Lshift = grp ? 13 : 12, L = 1 << Lshift, bbase = grp ? 8 : 0, nbat = grp ? 4 : 8, NC = L >> 4;
            const float* modl = MOD + ((size_t)l * 12 + bbase) * 6144;

            if (l == 0 && grp == 0) {
                if (bx < 32) { for (int g = bx; g < 32; g += G) ssm_gen(a, 0, g, (LAS float*)lds, BTS, BTY, A16, wave); }
                else convert_job(a, ws, 0, 3, lds, wave, (bx - 32) * NWAVES + wave, (G - 32) * NWAVES);
            }
            norm_rows(l == 0 ? a.in[grp] : xg, Hb, a.in[6] + l * 1024, modl, 0, 1024, Lshift, gw, NGW, 0);
            xcd_barrier(xbar);

#ifndef NO_P2
            {
                pg8::GridOrder S; S.init(MG, INCOLS, G, bx, Hb, WIN, 1024, 1024);
                EpiInproj E{Qb, Kb, Vb, SSMA, GA, GS, ROPE, L - 1};
                pg8::gemm_phase(lds, wave, 1024, 1024, 1024, S, E);
            }
#endif
            xcd_barrier(xbar);

#ifndef NO_P3
            {
                pg8::SsmOrder S{(const char*)SSMA, (const char*)BTS, (size_t)256 * 256 * 2, G, vcu};
                EpiS E{Sb};
                pg8::gemm_phase(lds, wave, 256, 512, 256, S, E);
            }
#endif
            xcd_barrier(xbar);

#ifndef NO_P4
            {
                const int nitem = nbat * 64;
                const int lane = fresh_lane();
                for (int it = wave * G + bx; it < nitem; it += NGW) {
                    const int dir = it & 1, g = (it >> 1) & 31, b = it >> 6;
                    const float ar = A16[((g * 2 + dir) * 64 + lane) * 2], ai = A16[((g * 2 + dir) * 64 + lane) * 2 + 1];
                    float hr = 0.f, hi = 0.f;
                    const size_t rbase = (size_t)g * NROW + (size_t)b * NC;
                    for (int c0 = 0; c0 < NC; c0 += 16) {
                        float sr[16], si[16];
#pragma unroll
                        for (int e = 0; e < 16; ++e) { const int c = dir ? NC - 1 - (c0 + e) : c0 + e; const float* sp = Sb + (rbase + c) * 256 + dir * 128 + lane; sr[e] = sp[0]; si[e] = sp[64]; }
#pragma unroll
                        for (int e = 0; e < 16; ++e) { const int c = dir ? NC - 1 - (c0 + e) : c0 + e; bf16_t* hp = SSMA + (rbase + c) * 512 + 256 + dir * 128 + lane;
                            hp[0] = (bf16_t)(cvt_pk_bf16(hr, 0.f) & 0xffffu); hp[64] = (bf16_t)(cvt_pk_bf16(hi, 0.f) & 0xffffu);
                            const float t = ar * hr - ai * hi + sr[e]; hi = ar * hi + ai * hr + si[e]; hr = t; }
                    }
                }
                if (wave >= 2) {
                    if (grp == 0) convert_job(a, ws, l, 4, lds, wave, bx * 6 + wave - 2, G * 6);
                    else if (l + 1 < DEPTH) convert_job(a, ws, l + 1, 1, lds, wave, bx * 6 + wave - 2, G * 6);
                }
            }
#endif
            xcd_barrier(xbar);

#ifndef NO_P5
            {
                const float lam_init = __uint_as_float(__builtin_amdgcn_readfirstlane(l == 0 ? 0x3e4ccccdu : l == 1 ? 0x3eb60549u : l == 2 ? 0x3ef1014cu : 0x3f0e59d5u));
                float lam;
                { const int lane = fresh_lane();
                  const float q1 = a.in[8][l * 64 + lane] * a.in[9][l * 64 + lane], q2 = a.in[10][l * 64 + lane] * a.in[11][l * 64 + lane];
                  lam = expf(wave_sum(q1)) - expf(wave_sum(q2)) + lam_init; }
                const int NQB = L >> 8;
                {
                pg8::SsmOrder S{(const char*)SSMA, (const char*)BTY, (size_t)256 * 512 * 2, G, vcu};
                EpiY E{SSMA, Zb, a.in[21] + l * 512};
                pg8::gemm_phase(lds, wave, 512, 512, 512, S, E);
                }
                __syncthreads();
#ifndef NO_P5A
                for (int unit = vcu; unit < 512; unit += G) {
                    const int bh = unit / NQB, qb = unit % NQB, b = bh >> 2, h = bh & 3;
                    const size_t row0 = (size_t)b * L + (size_t)qb * 256;
                    f32x16 o[4]; float rli[16];
                    att::attn_pass(Qb + row0 * 512 + h * 128, Kb + (size_t)b * L * 512 + h * 128, Vb + (size_t)b * L * 512 + h * 128, L, (LAS char*)lds, wave, o, rli);
                    {
                        f32x4* p = (f32x4*)STASH + (size_t)wave * 1024 + (fresh_lane());
#pragma unroll
                        for (int d0 = 0; d0 < 4; ++d0)
#pragma unroll
                            for (int r4 = 0; r4 < 4; ++r4) {
                                f32x4 v; v[0] = o[d0][4 * r4] * rli[4 * r4]; v[1] = o[d0][4 * r4 + 1] * rli[4 * r4 + 1]; v[2] = o[d0][4 * r4 + 2] * rli[4 * r4 + 2]; v[3] = o[d0][4 * r4 + 3] * rli[4 * r4 + 3];
                                p[(d0 * 4 + r4) * 64] = v; }
                    }
                    att::attn_pass(Qb + row0 * 512 + h * 128 + 64, Kb + (size_t)b * L * 512 + h * 128 + 64, Vb + (size_t)b * L * 512 + h * 128, L, (LAS char*)lds, wave, o, rli);
                    const int lane = fresh_lane(), r32 = lane & 31, hi = lane >> 5;
                    float ss[16];
#pragma unroll
                    for (int r = 0; r < 16; ++r) ss[r] = 0.f;
                    {
                        const f32x4* p = (const f32x4*)STASH + (size_t)wave * 1024 + lane;
#pragma unroll
                        for (int d0 = 0; d0 < 4; ++d0)
#pragma unroll
                            for (int r4 = 0; r4 < 4; ++r4) { const f32x4 t = p[(d0 * 4 + r4) * 64];
#pragma unroll
                                for (int e = 0; e < 4; ++e) { const int r = 4 * r4 + e; const float v = t[e] - lam * (o[d0][r] * rli[r]); o[d0][r] = v; ss[r] += v * v; } }
                    }
                    float sg[4];
#pragma unroll
                    for (int d0 = 0; d0 < 4; ++d0) sg[d0] = a.in[12][l * 128 + d0 * 32 + r32] * (1.0f - lam_init);
#pragma unroll
                    for (int r = 0; r < 16; ++r) {
                        float s = ss[r];
                        s = half_sum(s);
                        const float rs = rsqrtf(s * (1.0f / 128.0f) + EPS);
                        bf16_t* op = Qb + (row0 + wave * 32 + att::crow(r, hi)) * 512 + h * 128 + r32;
#pragma unroll
                        for (int d0 = 0; d0 < 4; ++d0) op[d0 * 32] = (bf16_t)(cvt_pk_bf16(o[d0][r] * rs * sg[d0], 0.f) & 0xffffu);
                    }
                }
#endif
            }
#endif
            xcd_barrier(xbar);

#ifndef NO_P6
            {
                pg8::MergeOrder S{(const char*)Zb, (const char*)Qb, (const char*)WGLU, (const char*)WATT, G, vcu};
                EpiMerge E{GA, GS, a.in[23] + l * 2048};
                pg8::gemm_phase(lds, wave, 512, 512, 512, S, E);
            }
#endif
            xcd_barrier(xbar);

#ifndef NO_P7
            {
                pg8::GridOrder S; S.init(MG, D, G, bx, GA, WO, 1024, 1024);
                EpiResid E{l == 0 ? a.in[grp] : xg, xg, modl + 2048, Lshift};
                pg8::gemm_phase(lds, wave, 1024, 1024, 1024, S, E);
            }
#endif
            xcd_barrier(xbar);

            if (grp == 1 && l + 1 < DEPTH) {
                if (bx < 32) { for (int g = bx; g < 32; g += G) ssm_gen(a, l + 1, g, (LAS float*)lds, BTS, BTY, A16, wave); }
                else convert_job(a, ws, l + 1, 2, lds, wave, (bx - 32) * NWAVES + wave, (G - 32) * NWAVES);
            }
            norm_rows(xg, Hb, a.in[25] + l * 1024, modl, 3072, 4096, Lshift, gw, NGW, 0);
            xcd_barrier(xbar);

#ifndef NO_P9
            {
                pg8::GridOrder S; S.init(MG, 2 * DFF, G, bx, Hb, WFI, 1024, 1024);
                EpiFfnIn E{ACT};
                pg8::gemm_phase(lds, wave, 1024, 1024, 1024, S, E);
            }
#endif
            xcd_barrier(xbar);

#ifndef NO_P10
            {
                pg8::GridOrder S; S.init(MG, D, G, bx, ACT, WFO, DFF, DFF);
                EpiResid E{xg, xg, modl + 5120, Lshift};
                pg8::gemm_phase(lds, wave, DFF, DFF, DFF, S, E);
            }
#endif
            xcd_barrier(xbar);
        }
    }

    {
        const int lane = fresh_lane();
        f32x4 gv[4];
#pragma unroll
        for (int j = 0; j < 4; ++j) gv[j] = *(const f32x4*)(a.in[28] + 4 * lane + 256 * j);
        for (int row = gw; row < 2 * MG; row += 4 * NGW) {
            f32x4 v[4][4]; float sc[4];
#pragma unroll
            for (int q = 0; q < 4; ++q) { const int r = row + q * NGW < 2 * MG ? row + q * NGW : row; const f32x4* xr = (const f32x4*)(a.out + (size_t)r * D) + lane;
#pragma unroll
                for (int j = 0; j < 4; ++j) v[q][j] = xr[64 * j]; }
#pragma unroll
            for (int q = 0; q < 4; ++q) { float t = 0.f;
#pragma unroll
                for (int j = 0; j < 4; ++j) t += (v[q][j].x * v[q][j].x + v[q][j].y * v[q][j].y) + (v[q][j].z * v[q][j].z + v[q][j].w * v[q][j].w);
                sc[q] = rsqrtf(wave_sum(t) * (1.f / D) + EPS); }
#pragma unroll
            for (int q = 0; q < 4; ++q) { if (row + q * NGW < 2 * MG) { f32x4* xr = (f32x4*)(a.out + (size_t)(row + q * NGW) * D) + lane;
#pragma unroll
                for (int j = 0; j < 4; ++j) xr[64 * j] = v[q][j] * sc[q] * gv[j]; } }
        }
    }
}

extern "C" void kernel_launch(void* const* d_in, const int* in_sizes, int n_in, void* d_out, int out_size, void* d_ws, size_t ws_size, hipStream_t stream) {
    static int grid = 0;
    if (grid == 0) {
        if (n_in != 29 || out_size != 2 * MG * D || ws_size < WS_END) { fprintf(stderr, "kernel_launch: unexpected shapes (n_in %d out %d ws %zu)\n", n_in, out_size, ws_size); grid = -1; return; }
        int dev = 0, cus = 0, per_cu = 0;
        if (hipGetDevice(&dev) != hipSuccess || hipDeviceGetAttribute(&cus, hipDeviceAttributeMultiprocessorCount, dev) != hipSuccess) { grid = -1; return; }
        if (hipFuncSetAttribute((const void*)mega, hipFuncAttributeMaxDynamicSharedMemorySize, LDS_BYTES) != hipSuccess) { fprintf(stderr, "kernel_launch: hipFuncSetAttribute failed\n"); grid = -1; return; }
        if (hipOccupancyMaxActiveBlocksPerMultiprocessor(&per_cu, (const void*)mega, NTHREADS, LDS_BYTES) != hipSuccess || per_cu < 1) { fprintf(stderr, "kernel_launch: occupancy query gave %d\n", per_cu); per_cu = 1; }
        (void)hipGetLastError();
        grid = cus * per_cu;
    }
    if (grid < 0) return;
    Args a{};
    for (int i = 0; i < 29; ++i) a.in[i] = (const float*)d_in[i];
    a.out = (float*)d_out; a.ws = (unsigned char*)d_ws;
    void* args[] = {&a};
    const hipError_t e = hipLaunchCooperativeKernel((const void*)mega, dim3(grid), dim3(NTHREADS), args, LDS_BYTES, stream);
    if (e != hipSuccess) fprintf(stderr, "kernel_launch: cooperative launch failed: %s (grid %d)\n", hipGetErrorString(e), grid);
}
```

```cpp
#include <hip/hip_runtime.h>
#include <hip/hip_cooperative_groups.h>
#include <cstdio>
#include <cstdint>
namespace cg = cooperative_groups;

#define LAS __attribute__((address_space(3)))
typedef unsigned short bf16_t;
typedef short bf16x8 __attribute__((ext_vector_type(8)));
typedef short s16x4 __attribute__((ext_vector_type(4)));
typedef float f32x4 __attribute__((ext_vector_type(4)));
typedef float f32x2 __attribute__((ext_vector_type(2)));
typedef float f32x16 __attribute__((ext_vector_type(16)));
typedef unsigned u32x4 __attribute__((ext_vector_type(4)));
typedef unsigned u32x2 __attribute__((ext_vector_type(2)));

constexpr int D = 1024, DEPTH = 4, DFF = 2816, INCOLS = 4096;
constexpr int MG = 32768;
constexpr int NROW = MG / 16;
constexpr float EPS = 1e-6f;
constexpr float QSC = 0.125f * 1.4426950408889634f;
constexpr int NTHREADS = 512, NWAVES = 8;

constexpr size_t MiB = 1u << 20;
constexpr size_t WS_MOD = 0;
constexpr size_t WS_ROPE = 2 * MiB;
constexpr size_t WS_A16 = 4 * MiB;
constexpr size_t WS_WIN = 5 * MiB;
constexpr size_t WS_WATT = 13 * MiB;
constexpr size_t WS_WGLU = 14 * MiB;
constexpr size_t WS_WO = 16 * MiB;
constexpr size_t WS_WFI = 18 * MiB;
constexpr size_t WS_WFO = 29 * MiB;
constexpr size_t WS_BTS = 35 * MiB;
constexpr size_t WS_BTY = 39 * MiB;
constexpr size_t WS_STASH = 47 * MiB;
constexpr size_t WS_H = 111 * MiB;
constexpr size_t WS_Q = 175 * MiB;
constexpr size_t WS_K = 207 * MiB;
constexpr size_t WS_V = 239 * MiB;
constexpr size_t WS_SSMA = 271 * MiB;
constexpr size_t WS_GA = 335 * MiB;
constexpr size_t WS_GS = 399 * MiB;
constexpr size_t WS_ACT = 175 * MiB;
constexpr size_t WS_END = 463 * MiB;
constexpr size_t WS_BAR = 4 * MiB + 768 * 1024;
constexpr int LDS_MISC = 131072;
constexpr int LDS_BYTES = 135168;

struct Args { const float* in[29]; float* out; unsigned char* ws; };

__device__ __forceinline__ int fresh_lane() { int l; asm volatile("v_mbcnt_lo_u32_b32 %0, -1, 0\n\tv_mbcnt_hi_u32_b32 %0, -1, %0" : "=v"(l)); return l; }
__device__ __forceinline__ int fresh_tid(int wave) { return wave * 64 + fresh_lane(); }
typedef __attribute__((address_space(1))) unsigned char gas_u8;
__device__ __forceinline__ unsigned char* fresh_ptr(unsigned char* p) { gas_u8* g = (gas_u8*)p; asm volatile("" : "+s"(g)); return (unsigned char*)g; }
typedef __bf16 bf16x2_t __attribute__((ext_vector_type(2)));
__device__ __forceinline__ unsigned cvt_pk_bf16(float lo, float hi) { const f32x2 v = {lo, hi}; const bf16x2_t b = __builtin_convertvector(v, bf16x2_t); return __builtin_bit_cast(unsigned, b); }
__device__ __forceinline__ float bf2f(unsigned short b) { return __uint_as_float(((unsigned)b) << 16); }
__device__ __forceinline__ float bflo(unsigned w) { return __uint_as_float(w << 16); }
__device__ __forceinline__ float bfhi(unsigned w) { return __uint_as_float(w & 0xffff0000u); }
__device__ __forceinline__ float sigmoidf_(float x) { return __builtin_amdgcn_rcpf(1.0f + __expf(-x)); }
__device__ __forceinline__ float siluf_(float x) { return x * __builtin_amdgcn_rcpf(1.0f + __expf(-x)); }
__device__ __forceinline__ float gelu_tanh(float y) { const float z = 0.7978845608028654f * (y + 0.044715f * y * y * y); const float t = 1.0f - 2.0f * __builtin_amdgcn_rcpf(1.0f + __expf(2.0f * z)); return 0.5f * y * (1.0f + t); }
template <int M> __device__ __forceinline__ float swz_xor(float v) { return __int_as_float(__builtin_amdgcn_ds_swizzle(__float_as_int(v), (M << 10) | 0x1f)); }
__device__ __forceinline__ float half_sum(float v) { v += swz_xor<1>(v); v += swz_xor<2>(v); v += swz_xor<4>(v); v += swz_xor<8>(v); v += swz_xor<16>(v); return v; }
__device__ __forceinline__ float wave_sum(float v) {
    v = half_sum(v);
    auto rr = __builtin_amdgcn_permlane32_swap(__float_as_uint(v), __float_as_uint(v), false, false);
    return __uint_as_float(rr[0]) + __uint_as_float(rr[1]);
}
__device__ __forceinline__ u32x4 pack8(f32x4 a, f32x4 b) { u32x4 w; w.x = cvt_pk_bf16(a[0], a[1]); w.y = cvt_pk_bf16(a[2], a[3]); w.z = cvt_pk_bf16(b[0], b[1]); w.w = cvt_pk_bf16(b[2], b[3]); return w; }

namespace pg8 {
constexpr int BM = 256, BK = 64, HALF = 128, HTB = HALF * BK * 2, STAGE_BYTES = 8 * HTB, NXCD = 8, WGM = 8;
__host__ __device__ __forceinline__ int lds_byte(int r, int c) { const int st = (r >> 4) * 2 + (c >> 5), rr = r & 15, cc = c & 31, ob = rr * 64 + cc * 2; return st * 1024 + (ob ^ (((ob >> 9) & 1) << 5)); }
__host__ __device__ __forceinline__ void stage_rc(int b, int& R, int& C) { const int st = b / 1024, sb = b % 1024, swz = sb ^ (((sb >> 9) & 1) << 5); R = (st >> 1) * 16 + swz / 64; C = (st & 1) * 32 + (swz % 64) / 2; }
__host__ __device__ __forceinline__ int perm32(int rho) { const int n = rho >> 4, i = rho & 15; return 8 * (i >> 2) + 4 * n + (i & 3); }
struct Unit { const char* a; const char* b; int pm, pn, aux; };
template <class Epi, class Sched>
__device__ __forceinline__ void gemm_phase(LAS unsigned char* lds, const int wid, const int K, const int lda, const int ldb, const Sched& S, const Epi& E) {
    const int lane = fresh_lane(), tid = wid * 64 + lane, wr = wid >> 2, wc = wid & 3, fr = lane & 15, fq = lane >> 4;
    const int nt = K / BK;
    unsigned voffA, voffB;
    { int R, C; stage_rc(tid * 16, R, C); const int Rb = Epi::PERM ? ((R & ~31) + perm32(R & 31)) : R;
      voffA = (unsigned)(R * lda + C) * 2u; voffB = (unsigned)(Rb * ldb + C) * 2u; }
    const size_t qvoffA = (size_t)64 * lda * 2, qvoffB = (size_t)64 * ldb * 2;
    const size_t kstep = (size_t)(BK * 2);
    const size_t hA = (size_t)HALF * lda * 2, hB = (size_t)HALF * ldb * 2;
    const unsigned ldsw = (unsigned)wid * 1024u;
    const int aoff = lds_byte(wr * 64 + fr, fq * 8), boff = lds_byte(wc * 32 + fr, fq * 8);
#define PG8_SA(b, h) (((b) * 2 + (h)) * HTB)
#define PG8_SB(b, h) ((4 + (b) * 2 + (h)) * HTB)
#define PG8_STAGE(bufoff, gbase, voff) do { _Pragma("unroll") for (int _i = 0; _i < 2; ++_i) \
        __builtin_amdgcn_global_load_lds((const unsigned*)((const char*)(gbase) + (size_t)_i * q##voff + (voff)), (LAS unsigned*)(lds + (bufoff) + ldsw + _i * 8192), 16, 0, 0); } while (0)
#define PG8_LDA(dst, b, h) do { _Pragma("unroll") for (int m = 0; m < 4; ++m) _Pragma("unroll") for (int k = 0; k < 2; ++k) dst[m][k] = *(const LAS bf16x8*)(lds + PG8_SA(b, h) + aoff + m * 2048 + k * 1024); } while (0)
#define PG8_LDB(dst, b, h) do { _Pragma("unroll") for (int n = 0; n < 2; ++n) _Pragma("unroll") for (int k = 0; k < 2; ++k) dst[n][k] = *(const LAS bf16x8*)(lds + PG8_SB(b, h) + boff + n * 2048 + k * 1024); } while (0)
#define PG8_MMA(ai, bj, At, Bt) do { __builtin_amdgcn_s_setprio(1); _Pragma("unroll") for (int m = 0; m < 4; ++m) _Pragma("unroll") for (int n = 0; n < 2; ++n) _Pragma("unroll") for (int k = 0; k < 2; ++k) \
        acc[ai][bj][m][n] = __builtin_amdgcn_mfma_f32_16x16x32_bf16(Bt[n][k], At[m][k], acc[ai][bj][m][n], 0, 0, 0); __builtin_amdgcn_s_setprio(0); } while (0)
#define PG8_WAIT_V(n) asm volatile("s_waitcnt vmcnt(" #n ")" ::: "memory")
#define PG8_WAIT_L(n) asm volatile("s_waitcnt lgkmcnt(" #n ")" ::: "memory")
#define PG8_BAR __builtin_amdgcn_s_barrier()
#define PG8_SCHED __builtin_amdgcn_sched_barrier(0)
    Unit cur, nxt; int ui = 0;
    if (!S.next(0, cur)) return;
    f32x4 acc[2][2][4][2];
#pragma unroll
    for (int a = 0; a < 2; ++a)
#pragma unroll
        for (int b = 0; b < 2; ++b)
#pragma unroll
            for (int m = 0; m < 4; ++m)
#pragma unroll
                for (int n = 0; n < 2; ++n) acc[a][b][m][n] = (f32x4){0.f, 0.f, 0.f, 0.f};
    bf16x8 At[4][2], B0[2][2], B1[2][2];
    const char* cA = cur.a; const char* cB = cur.b;
    PG8_STAGE(PG8_SB(0, 0), cB, voffB); PG8_STAGE(PG8_SB(0, 1), cB + hB, voffB); PG8_STAGE(PG8_SA(0, 0), cA, voffA); PG8_STAGE(PG8_SA(0, 1), cA + hA, voffA);
    if (wr == 1) PG8_BAR;
    PG8_WAIT_V(2); PG8_BAR;
    PG8_STAGE(PG8_SB(1, 0), cB + kstep, voffB); PG8_STAGE(PG8_SA(1, 0), cA + kstep, voffA); PG8_STAGE(PG8_SB(1, 1), cB + hB + kstep, voffB);
    PG8_WAIT_V(6); PG8_BAR;
    for (;;) {
        const bool has_next = S.next(ui + 1, nxt);
        const char* nA = has_next ? nxt.a : cA; const char* nB = has_next ? nxt.b : cB;
        for (int t = 0; t < nt; t += 2) {
            const bool last = (t == nt - 2);
            const char* a1 = cA + (size_t)(t + 1) * kstep;
            const char* a2 = last ? nA : cA + (size_t)(t + 2) * kstep; const char* b2 = last ? nB : cB + (size_t)(t + 2) * kstep;
            const char* a3 = a2 + kstep; const char* b3 = b2 + kstep;
            PG8_LDB(B0, 0, 0); PG8_LDB(B1, 0, 1); PG8_SCHED; PG8_LDA(At, 0, 0); PG8_STAGE(PG8_SA(1, 1), a1 + hA, voffA);
            PG8_WAIT_V(8); PG8_WAIT_L(0); PG8_BAR; PG8_MMA(0, 0, At, B0); PG8_MMA(0, 1, At, B1); PG8_BAR; PG8_SCHED;
            PG8_LDA(At, 0, 1); PG8_STAGE(PG8_SB(0, 0), b2, voffB); PG8_STAGE(PG8_SB(0, 1), b2 + hB, voffB); PG8_STAGE(PG8_SA(0, 0), a2, voffA);
            PG8_WAIT_V(8); PG8_WAIT_L(0); PG8_BAR; PG8_MMA(1, 0, At, B0); PG8_MMA(1, 1, At, B1); PG8_BAR; PG8_SCHED;
            PG8_LDB(B0, 1, 0); PG8_LDB(B1, 1, 1); PG8_SCHED; PG8_LDA(At, 1, 0); PG8_STAGE(PG8_SA(0, 1), a2 + hA, voffA);
            PG8_WAIT_V(8); PG8_WAIT_L(0); PG8_BAR; PG8_MMA(0, 0, At, B0); PG8_MMA(0, 1, At, B1); PG8_BAR; PG8_SCHED;
            PG8_LDA(At, 1, 1); PG8_STAGE(PG8_SB(1, 0), b3, voffB); PG8_STAGE(PG8_SB(1, 1), b3 + hB, voffB); PG8_STAGE(PG8_SA(1, 0), a3, voffA);
            PG8_WAIT_V(8); PG8_WAIT_L(0); PG8_BAR; PG8_MMA(1, 0, At, B0); PG8_MMA(1, 1, At, B1); PG8_BAR; PG8_SCHED;
        }
        if (wr == 0) PG8_BAR;
        E(acc, cur, wr, wc, fr, fq);
        if (!has_next) break;
#pragma unroll
        for (int a = 0; a < 2; ++a)
#pragma unroll
            for (int b = 0; b < 2; ++b)
#pragma unroll
                for (int m = 0; m < 4; ++m)
#pragma unroll
                    for (int n = 0; n < 2; ++n) acc[a][b][m][n] = (f32x4){0.f, 0.f, 0.f, 0.f};
        cur = nxt; cA = nA; cB = nB; ++ui;
        if (wr == 1) PG8_BAR;
    }
    PG8_WAIT_V(0);
    PG8_BAR;
#undef PG8_SA
#undef PG8_SB
#undef PG8_STAGE
#undef PG8_LDA
#undef PG8_LDB
#undef PG8_MMA
#undef PG8_WAIT_V
#undef PG8_WAIT_L
#undef PG8_BAR
#undef PG8_SCHED
}

struct GridOrder {
    int nM, nN, nwg, G, c; const char* A; const char* B; size_t ta, tb;
    __device__ void init(int M, int N, int G_, int c_, const void* A_, const void* B_, int lda, int ldb) { nM = M / BM; nN = N / BM; nwg = nM * nN; G = G_; c = c_; A = (const char*)A_; B = (const char*)B_; ta = (size_t)BM * lda * 2; tb = (size_t)BM * ldb * 2; }
    __device__ bool next(int i, Unit& u) const {
        const long L = (long)i * G + c; if (L >= nwg) return false;
        int wgid = (int)L; { const int q = nwg / NXCD, r = nwg % NXCD, xcd = wgid % NXCD, off = wgid / NXCD; wgid = (xcd < r ? xcd * (q + 1) : r * (q + 1) + (xcd - r) * q) + off; }
        const int nig = WGM * nN, gid = wgid / nig, fm = gid * WGM, gsz = (nM - fm) < WGM ? (nM - fm) : WGM;
        u.pm = fm + ((wgid % nig) % gsz); u.pn = (wgid % nig) / gsz; u.aux = 0;
        u.a = A + (size_t)u.pm * ta; u.b = B + (size_t)u.pn * tb; return true;
    }
};
struct SsmOrder {
    const char* A; const char* B; size_t tb; int G, c;
    __device__ bool next(int i, Unit& u) const {
        const int w = i * G + c; if (w >= 256) return false;
        u.pm = w; u.pn = 0; u.aux = 0; u.a = A + (size_t)w * 256 * 512 * 2; u.b = B + (size_t)(w >> 3) * tb; return true;
    }
};
struct MergeOrder {
    const char* Z; const char* ON; const char* WG; const char* WA; int G, c;
    __device__ bool next(int i, Unit& u) const {
        const int item = c + (i / 6) * G; if (item >= 256) return false;
        const int sub = i % 6, panel = item >> 1, half = item & 1, jj = half * 2 + sub / 3, t = sub % 3;
        u.pm = panel;
        if (t < 2) { const int gu = 2 * jj + t; u.pn = gu; u.aux = 0; u.a = Z + (size_t)panel * 256 * 512 * 2; u.b = WG + (size_t)gu * 256 * 512 * 2; }
        else { u.pn = jj; u.aux = 1; u.a = ON + (size_t)panel * 256 * 512 * 2; u.b = WA + (size_t)jj * 256 * 512 * 2; }
        return true;
    }
};
}
using pg8::Unit;
typedef f32x4 Acc[2][2][4][2];

struct EpiInproj {
    static constexpr bool PERM = true;
    bf16_t *Q, *Kb, *V, *SSMA, *GA, *GS; const float* rope; int Lmask;
    __device__ __forceinline__ void operator()(const Acc& acc, const Unit& u, int wr, int wc, int fr, int fq) const {
        { const int ln = fresh_lane(); fr = ln & 15; fq = ln >> 4; }
        const int reg = u.pn;
        if (reg < 4) {
            const int i0 = ((wc * 32 + fq * 8) & 63) >> 1;
            bf16_t* base = (reg < 2 ? Q + u.pn * 256 : Kb + (u.pn * 256 - 512)) + wc * 32 + fq * 8;
#pragma unroll
            for (int ai = 0; ai < 2; ++ai) {
                const int row0 = u.pm * 256 + ai * 128 + wr * 64 + fr;
                f32x4 r0[4], r1[4];
#pragma unroll
                for (int m = 0; m < 4; ++m) { const f32x4* rp = (const f32x4*)(rope + ((size_t)((row0 + m * 16) & Lmask) * 32 + i0) * 2); r0[m] = rp[0]; r1[m] = rp[1]; }
#pragma unroll
                for (int m = 0; m < 4; ++m) asm volatile("" : "+v"(r0[m]), "+v"(r1[m]));
#pragma unroll
                for (int m = 0; m < 4; ++m)
#pragma unroll
                    for (int bj = 0; bj < 2; ++bj) {
                        const f32x4 v0 = acc[ai][bj][m][0], v1 = acc[ai][bj][m][1];
                        f32x4 w0, w1;
                        w0[0] = v0[0] * r0[m][0] - v0[1] * r0[m][1]; w0[1] = v0[1] * r0[m][0] + v0[0] * r0[m][1];
                        w0[2] = v0[2] * r0[m][2] - v0[3] * r0[m][3]; w0[3] = v0[3] * r0[m][2] + v0[2] * r0[m][3];
                        w1[0] = v1[0] * r1[m][0] - v1[1] * r1[m][1]; w1[1] = v1[1] * r1[m][0] + v1[0] * r1[m][1];
                        w1[2] = v1[2] * r1[m][2] - v1[3] * r1[m][3]; w1[3] = v1[3] * r1[m][2] + v1[2] * r1[m][3];
                        if (reg < 2) { w0 = w0 * QSC; w1 = w1 * QSC; }
                        *(u32x4*)(base + (size_t)(row0 + m * 16) * 512 + bj * 128) = pack8(w0, w1);
                    }
            }
            return;
        }
#pragma unroll
        for (int ai = 0; ai < 2; ++ai)
#pragma unroll
            for (int m = 0; m < 4; ++m) {
                const int row = u.pm * 256 + ai * 128 + wr * 64 + m * 16 + fr;
#pragma unroll
                for (int bj = 0; bj < 2; ++bj) {
                    const int c0 = u.pn * 256 + bj * 128 + wc * 32 + fq * 8;
                    f32x4 v0 = acc[ai][bj][m][0], v1 = acc[ai][bj][m][1];
                    bf16_t* dst;
                    if (reg < 6) {
                        dst = V + (size_t)row * 512 + (c0 - 1024);
                    } else if (reg < 8) {
                        const int c = c0 - 1536, g = c >> 4, ch0 = c & 15;
                        dst = SSMA + ((size_t)(g * NROW + (row >> 4)) * 512 + (row & 15) * 16 + ch0);
                    } else {
#pragma unroll
                        for (int i = 0; i < 4; ++i) { v0[i] = sigmoidf_(v0[i]); v1[i] = sigmoidf_(v1[i]); }
                        dst = (reg < 12 ? GA + (c0 - 2048) : GS + (c0 - 3072)) + (size_t)row * 1024;
                    }
                    *(u32x4*)dst = pack8(v0, v1);
                }
            }
    }
};
struct EpiResid {
    static constexpr bool PERM = false;
    const float* xr; float* x; const float* gt; int Lshift;
    __device__ __forceinline__ void operator()(const Acc& acc, const Unit& u, int wr, int wc, int fr, int fq) const {
        { const int ln = fresh_lane(); fr = ln & 15; fq = ln >> 4; }
        const int col0 = u.pn * 256 + wc * 32 + fq * 4;
#pragma unroll
        for (int ai = 0; ai < 2; ++ai) {
            const int row0 = u.pm * 256 + ai * 128 + wr * 64 + fr; const int b = row0 >> Lshift;
            float* xp = x + (size_t)row0 * 1024 + col0; const float* xq = xr + (size_t)row0 * 1024 + col0;
            f32x4 xv[4][2][2], g4[2][2];
#pragma unroll
            for (int bj = 0; bj < 2; ++bj)
#pragma unroll
                for (int n = 0; n < 2; ++n) g4[bj][n] = *(const f32x4*)(gt + (size_t)b * 6144 + col0 + bj * 128 + n * 16);
#pragma unroll
            for (int m = 0; m < 4; ++m)
#pragma unroll
                for (int bj = 0; bj < 2; ++bj)
#pragma unroll
                    for (int n = 0; n < 2; ++n) xv[m][bj][n] = *(const f32x4*)(xq + (size_t)m * 16 * 1024 + bj * 128 + n * 16);
#pragma unroll
            for (int m = 0; m < 4; ++m)
#pragma unroll
                for (int bj = 0; bj < 2; ++bj)
#pragma unroll
                    for (int n = 0; n < 2; ++n) asm volatile("" : "+v"(xv[m][bj][n]));
#pragma unroll
            for (int m = 0; m < 4; ++m)
#pragma unroll
                for (int bj = 0; bj < 2; ++bj)
#pragma unroll
                    for (int n = 0; n < 2; ++n) *(f32x4*)(xp + (size_t)m * 16 * 1024 + bj * 128 + n * 16) = xv[m][bj][n] + g4[bj][n] * acc[ai][bj][m][n];
        }
    }
};
struct EpiFfnIn {
    static constexpr bool PERM = true;
    bf16_t* ACT;
    __device__ __forceinline__ void operator()(const Acc& acc, const Unit& u, int wr, int wc, int fr, int fq) const {
        { const int ln = fresh_lane(); fr = ln & 15; fq = ln >> 4; }
#pragma unroll
        for (int ai = 0; ai < 2; ++ai)
#pragma unroll
            for (int m = 0; m < 4; ++m) {
                const int row = u.pm * 256 + ai * 128 + wr * 64 + m * 16 + fr; const int c0 = u.pn * 128 + wc * 32 + fq * 8;
                f32x4 a0, a1;
#pragma unroll
                for (int i = 0; i < 4; ++i) { a0[i] = siluf_(acc[ai][0][m][0][i]) * acc[ai][1][m][0][i]; a1[i] = siluf_(acc[ai][0][m][1][i]) * acc[ai][1][m][1][i]; }
                *(u32x4*)(ACT + (size_t)row * DFF + c0) = pack8(a0, a1);
            }
    }
};
struct EpiS {
    static constexpr bool PERM = false;
    float* S;
    __device__ __forceinline__ void operator()(const Acc& acc, const Unit& u, int wr, int wc, int fr, int fq) const {
        { const int ln = fresh_lane(); fr = ln & 15; fq = ln >> 4; }
#pragma unroll
        for (int ai = 0; ai < 2; ++ai)
#pragma unroll
            for (int m = 0; m < 4; ++m) {
                const size_t row = (size_t)u.pm * 256 + ai * 128 + wr * 64 + m * 16 + fr;
#pragma unroll
                for (int bj = 0; bj < 2; ++bj)
#pragma unroll
                    for (int n = 0; n < 2; ++n) *(f32x4*)(S + row * 256 + bj * 128 + wc * 32 + n * 16 + fq * 4) = acc[ai][bj][m][n];
            }
    }
};
struct EpiY {
    static constexpr bool PERM = true;
    const bf16_t* SSMA; bf16_t* Z; const float* dskip;
    __device__ __forceinline__ void operator()(const Acc& acc, const Unit& u, int wr, int wc, int fr, int fq) const {
        { const int ln = fresh_lane(); fr = ln & 15; fq = ln >> 4; }
        const int g = u.pm >> 3;
        const f32x4 d0 = *(const f32x4*)(dskip + g * 16 + 8 * (fq & 1)), d1 = *(const f32x4*)(dskip + g * 16 + 8 * (fq & 1) + 4);
#pragma unroll
        for (int ai = 0; ai < 2; ++ai) {
            const int rl0 = ai * 128 + wr * 64 + fr; const size_t arow0 = (size_t)u.pm * 256 + rl0; const int cr0 = (u.pm & 7) * 256 + rl0;
            const int nc0 = wc * 32 + fq * 8;
            u32x4 uw[4][2];
#pragma unroll
            for (int m = 0; m < 4; ++m)
#pragma unroll
                for (int bj = 0; bj < 2; ++bj) uw[m][bj] = *(const u32x4*)(SSMA + (arow0 + m * 16) * 512 + bj * 128 + nc0);
#pragma unroll
            for (int m = 0; m < 4; ++m)
#pragma unroll
                for (int bj = 0; bj < 2; ++bj) asm volatile("" : "+v"(uw[m][bj]));
#pragma unroll
            for (int m = 0; m < 4; ++m)
#pragma unroll
                for (int bj = 0; bj < 2; ++bj) {
                    const int tau = (bj * 128 + nc0) >> 4; const u32x4 w = uw[m][bj];
                    f32x4 y0 = acc[ai][bj][m][0], y1 = acc[ai][bj][m][1];
                    y0[0] += d0[0] * bflo(w.x); y0[1] += d0[1] * bfhi(w.x); y0[2] += d0[2] * bflo(w.y); y0[3] += d0[3] * bfhi(w.y);
                    y1[0] += d1[0] * bflo(w.z); y1[1] += d1[1] * bfhi(w.z); y1[2] += d1[2] * bflo(w.w); y1[3] += d1[3] * bfhi(w.w);
#pragma unroll
                    for (int i = 0; i < 4; ++i) { y0[i] = gelu_tanh(y0[i]); y1[i] = gelu_tanh(y1[i]); }
                    *(u32x4*)(Z + ((size_t)(cr0 + m * 16) * 16 + tau) * 512 + g * 16 + 8 * (fq & 1)) = pack8(y0, y1);
                }
        }
    }
};
struct EpiMerge {
    static constexpr bool PERM = true;
    bf16_t* GA; bf16_t* GS; const float* bglu;
    __device__ __forceinline__ void operator()(const Acc& acc, const Unit& u, int wr, int wc, int fr, int fq) const {
        { const int ln = fresh_lane(); fr = ln & 15; fq = ln >> 4; }
        if (u.aux == 0) {
            const int yc0 = u.pn * 128 + wc * 32 + fq * 8;
            const f32x4 bl0 = *(const f32x4*)(bglu + yc0), bl1 = *(const f32x4*)(bglu + yc0 + 4), bg0 = *(const f32x4*)(bglu + 1024 + yc0), bg1 = *(const f32x4*)(bglu + 1024 + yc0 + 4);
            bf16_t* gp0 = GS + (size_t)(u.pm * 256 + wr * 64 + fr) * 1024 + yc0;
            u32x4 gw[2][4];
#pragma unroll
            for (int ai = 0; ai < 2; ++ai)
#pragma unroll
                for (int m = 0; m < 4; ++m) gw[ai][m] = *(const u32x4*)(gp0 + (size_t)(ai * 128 + m * 16) * 1024);
#pragma unroll
            for (int ai = 0; ai < 2; ++ai)
#pragma unroll
                for (int m = 0; m < 4; ++m) asm volatile("" : "+v"(gw[ai][m]));
#pragma unroll
            for (int ai = 0; ai < 2; ++ai)
#pragma unroll
                for (int m = 0; m < 4; ++m) {
                    const u32x4 g = gw[ai][m];
                    f32x4 s0, s1;
                    s0[0] = bflo(g.x); s0[1] = bfhi(g.x); s0[2] = bflo(g.y); s0[3] = bfhi(g.y); s1[0] = bflo(g.z); s1[1] = bfhi(g.z); s1[2] = bflo(g.w); s1[3] = bfhi(g.w);
                    f32x4 y0, y1;
#pragma unroll
                    for (int i = 0; i < 4; ++i) { y0[i] = s0[i] * (acc[ai][0][m][0][i] + bl0[i]) * sigmoidf_(acc[ai][1][m][0][i] + bg0[i]); y1[i] = s1[i] * (acc[ai][0][m][1][i] + bl1[i]) * sigmoidf_(acc[ai][1][m][1][i] + bg1[i]); }
                    *(u32x4*)(gp0 + (size_t)(ai * 128 + m * 16) * 1024) = pack8(y0, y1);
                }
        } else {
#pragma unroll
            for (int ai = 0; ai < 2; ++ai) {
                const size_t roff = (size_t)(u.pm * 256 + ai * 128 + wr * 64 + fr) * 1024 + u.pn * 256 + wc * 32 + fq * 8;
                u32x4 gw[4][2], tw[4][2];
#pragma unroll
                for (int m = 0; m < 4; ++m)
#pragma unroll
                    for (int bj = 0; bj < 2; ++bj) { gw[m][bj] = *(const u32x4*)(GA + roff + (size_t)m * 16 * 1024 + bj * 128); tw[m][bj] = *(const u32x4*)(GS + roff + (size_t)m * 16 * 1024 + bj * 128); }
#pragma unroll
                for (int m = 0; m < 4; ++m)
#pragma unroll
                    for (int bj = 0; bj < 2; ++bj) asm volatile("" : "+v"(gw[m][bj]), "+v"(tw[m][bj]));
#pragma unroll
                for (int m = 0; m < 4; ++m)
#pragma unroll
                    for (int bj = 0; bj < 2; ++bj) {
                        const u32x4 g = gw[m][bj], t = tw[m][bj];
                        const f32x4 a0 = acc[ai][bj][m][0], a1 = acc[ai][bj][m][1];
                        f32x4 o0, o1;
                        o0[0] = bflo(g.x) * a0[0] + bflo(t.x); o0[1] = bfhi(g.x) * a0[1] + bfhi(t.x); o0[2] = bflo(g.y) * a0[2] + bflo(t.y); o0[3] = bfhi(g.y) * a0[3] + bfhi(t.y);
                        o1[0] = bflo(g.z) * a1[0] + bflo(t.z); o1[1] = bfhi(g.z) * a1[1] + bfhi(t.z); o1[2] = bflo(g.w) * a1[2] + bflo(t.w); o1[3] = bfhi(g.w) * a1[3] + bfhi(t.w);
                        *(u32x4*)(GA + roff + (size_t)m * 16 * 1024 + bj * 128) = pack8(o0, o1);
                    }
            }
        }
    }
};

namespace att {
constexpr int QBLK = 32, KVBLK = 64, LDX = 512;
constexpr int NSLOT = 4, SHM_V = 16384, SHM_K = 8192, OFF_K = NSLOT * SHM_V, OFF_WS = NSLOT * (SHM_V + SHM_K);
constexpr float SCALE = 0.125f, THR = 8.f;
#define KSWZ(row, colB) ((row) * 128 + ((colB) ^ ((((row) >> 1) & 7) << 4)))
#define SBAR() __builtin_amdgcn_sched_barrier(0)
__device__ __forceinline__ int crow(int r, int hi) { return (r & 3) + 8 * (r >> 2) + 4 * hi; }
__device__ __forceinline__ void partialSM(f32x16& p0, f32x16& p1, float& mhat, f32x16& negm, float& alpha, const bool first) {
    constexpr float THRL = THR * 1.4426950408889634f;
    float pmax = p0[0];
#pragma unroll
    for (int r = 1; r < 16; ++r) pmax = fmaxf(pmax, p0[r]);
#pragma unroll
    for (int r = 0; r < 16; ++r) pmax = fmaxf(pmax, p1[r]);
    { auto rr = __builtin_amdgcn_permlane32_swap(__float_as_uint(pmax), __float_as_uint(pmax), false, false);
      pmax = fmaxf(__uint_as_float(rr[0]), __uint_as_float(rr[1])); }
    if (__builtin_expect(!first && __all(pmax <= THRL), 1)) { alpha = 1.f; }
    else { const float dl = first ? pmax : fmaxf(pmax, 0.f); mhat += dl; alpha = first ? 0.f : __builtin_amdgcn_exp2f(-dl);
#pragma unroll
        for (int r = 0; r < 16; ++r) { p0[r] -= dl; p1[r] -= dl; }
#pragma unroll
        for (int r = 0; r < 16; ++r) negm[r] = -mhat; }
#pragma unroll
    for (int r = 0; r < 16; ++r) p0[r] = __builtin_amdgcn_exp2f(p0[r]);
}
__device__ __forceinline__ void finishSM(f32x16& p0, f32x16& p1, float alpha, float& l_reg, bf16x8& pa0, bf16x8& pa1, bf16x8& pa2, bf16x8& pa3) {
#pragma unroll
    for (int r = 0; r < 16; ++r) p1[r] = __builtin_amdgcn_exp2f(p1[r]);
    float ps = 0;
#pragma unroll
    for (int r = 0; r < 16; ++r) ps += p0[r];
#pragma unroll
    for (int r = 0; r < 16; ++r) ps += p1[r];
    { auto rr = __builtin_amdgcn_permlane32_swap(__float_as_uint(ps), __float_as_uint(ps), false, false);
      ps = __uint_as_float(rr[0]) + __uint_as_float(rr[1]); }
    l_reg = l_reg * alpha + ps;
#define PK4(P, BASE, OUT) do { unsigned a0 = cvt_pk_bf16(P[BASE + 0], P[BASE + 1]), a1 = cvt_pk_bf16(P[BASE + 2], P[BASE + 3]);   \
    unsigned b0 = cvt_pk_bf16(P[BASE + 4], P[BASE + 5]), b1 = cvt_pk_bf16(P[BASE + 6], P[BASE + 7]);                              \
    auto r0 = __builtin_amdgcn_permlane32_swap(a0, b0, false, false); auto r1 = __builtin_amdgcn_permlane32_swap(a1, b1, false, false); \
    u32x4 w = {r0[0], r1[0], r0[1], r1[1]}; OUT = __builtin_bit_cast(bf16x8, w); } while (0)
    PK4(p0, 0, pa0); PK4(p0, 8, pa1); PK4(p1, 0, pa2); PK4(p1, 8, pa3);
#undef PK4
}
__device__ __forceinline__ void qkt(f32x16& p0, f32x16& p1, const LAS char* Ks, const bf16x8* qr, const f32x16& negm, int r32, int hi) {
#pragma unroll
    for (int d0 = 0; d0 < 4; ++d0) { const int cb = (d0 * 16 + hi * 8) * 2;
        const bf16x8 b0 = *(const LAS bf16x8*)(Ks + KSWZ(r32, cb));
        const bf16x8 b1 = *(const LAS bf16x8*)(Ks + KSWZ(32 + r32, cb));
        if (d0 == 0) { p0 = __builtin_amdgcn_mfma_f32_32x32x16_bf16(b0, qr[0], negm, 0, 0, 0); p1 = __builtin_amdgcn_mfma_f32_32x32x16_bf16(b1, qr[0], negm, 0, 0, 0); }
        else { p0 = __builtin_amdgcn_mfma_f32_32x32x16_bf16(b0, qr[d0], p0, 0, 0, 0); p1 = __builtin_amdgcn_mfma_f32_32x32x16_bf16(b1, qr[d0], p1, 0, 0, 0); } }
}
__device__ __forceinline__ int v_st(int k, int c) { const int kk = (k & ~0xC) | ((k & 4) << 1) | ((k & 8) >> 1); return ((kk >> 3) * 4 + (c >> 5)) * 512 + ((kk & 7) * 32 + (c & 31)) * 2; }
__device__ __forceinline__ int v_rd_base(int lane) { return ((lane & 3) << 3) | (((lane >> 2) & 3) << 6) | (((lane >> 4) & 1) << 5) | (((lane >> 5) & 1) << 8); }
constexpr int v_rd_off(int d0, int ks, int half) { return d0 * 512 + ks * 4096 + half * 2048; }
template <int OFF> __device__ __forceinline__ s16x4 tr_read(int vb) {
    s16x4 r; asm volatile("ds_read_b64_tr_b16 %0, %1 offset:%2" : "=&v"(r) : "v"(vb), "i"(OFF) : "memory"); return r;
}
template <int D0> __device__ __forceinline__ void pv_one(f32x16& od, int vb, bf16x8 pa0, bf16x8 pa1, bf16x8 pa2, bf16x8 pa3) {
    const s16x4 l0 = tr_read<v_rd_off(D0, 0, 0)>(vb), h0 = tr_read<v_rd_off(D0, 0, 1)>(vb), l1 = tr_read<v_rd_off(D0, 1, 0)>(vb), h1 = tr_read<v_rd_off(D0, 1, 1)>(vb);
    const s16x4 l2 = tr_read<v_rd_off(D0, 2, 0)>(vb), h2 = tr_read<v_rd_off(D0, 2, 1)>(vb), l3 = tr_read<v_rd_off(D0, 3, 0)>(vb), h3 = tr_read<v_rd_off(D0, 3, 1)>(vb);
    asm volatile("s_waitcnt lgkmcnt(0)" ::: "memory"); SBAR();
#define PK(L, H) (bf16x8){L[0], L[1], L[2], L[3], H[0], H[1], H[2], H[3]}
    od = __builtin_amdgcn_mfma_f32_32x32x16_bf16(pa0, PK(l0, h0), od, 0, 0, 0);
    od = __builtin_amdgcn_mfma_f32_32x32x16_bf16(pa1, PK(l1, h1), od, 0, 0, 0);
    od = __builtin_amdgcn_mfma_f32_32x32x16_bf16(pa2, PK(l2, h2), od, 0, 0, 0);
    od = __builtin_amdgcn_mfma_f32_32x32x16_bf16(pa3, PK(l3, h3), od, 0, 0, 0);
#undef PK
}
__device__ __forceinline__ void pv_d0(f32x16* o, int vb, bf16x8 pa0, bf16x8 pa1, bf16x8 pa2, bf16x8 pa3) {
    pv_one<0>(o[0], vb, pa0, pa1, pa2, pa3); pv_one<1>(o[1], vb, pa0, pa1, pa2, pa3); pv_one<2>(o[2], vb, pa0, pa1, pa2, pa3); pv_one<3>(o[3], vb, pa0, pa1, pa2, pa3);
}
__device__ __forceinline__ void attn_pass(const bf16_t* __restrict__ Qb, const bf16_t* __restrict__ Kh, const bf16_t* __restrict__ Vh, int seq, LAS char* lds, const int wid, f32x16 (&o)[4], float (&rli)[16]) {
    const int lane = fresh_lane(), tid = wid * 64 + lane, r32 = lane & 31, hi = lane >> 5;
    LAS char* V_lds = lds; LAS char* K_lds = lds + OFF_K;
    LAS float* ws = (LAS float*)(lds + OFF_WS) + wid * 64; LAS float* li_l = ws; LAS float* al_l = ws + 32;
    float mhat = 0.f, l_reg = 0; f32x16 negm = f32x16{};
#pragma unroll
    for (int d = 0; d < 4; ++d) o[d] = f32x16{};
    bf16x8 qr[4];
    const bf16_t* Qw = Qb + (size_t)(wid * QBLK + r32) * LDX + hi * 8;
#pragma unroll
    for (int d0 = 0; d0 < 4; ++d0) qr[d0] = *(const bf16x8*)(Qw + d0 * 16);
    const int sr = tid >> 4, sc = (tid & 15) * 8, vst0 = v_st(sr, sc), vst1 = v_st(32 + sr, sc);
    const int kr = tid >> 3, kc = (tid & 7) * 8, kst = KSWZ(kr, kc * 2);
    const int vb0 = (int)(unsigned)(uintptr_t)V_lds + v_rd_base(lane);
    struct { bf16x8 vs0, vs1, ks0; } sr_[2];
#define SLOAD(i, k0) do { sr_[i].vs0 = *(const bf16x8*)(&Vh[(size_t)((k0) + sr) * LDX + sc]); sr_[i].vs1 = *(const bf16x8*)(&Vh[(size_t)((k0) + 32 + sr) * LDX + sc]); \
    sr_[i].ks0 = *(const bf16x8*)(&Kh[(size_t)((k0) + kr) * LDX + kc]); } while (0)
#define SWRITE(b, i) do { *(LAS bf16x8*)(V_lds + (b) * SHM_V + vst0) = sr_[i].vs0; *(LAS bf16x8*)(V_lds + (b) * SHM_V + vst1) = sr_[i].vs1; \
    *(LAS bf16x8*)(K_lds + (b) * SHM_K + kst) = sr_[i].ks0; } while (0)
#define SWAIT() asm volatile("s_waitcnt vmcnt(3)" ::: "memory")
#define RESC(a) do { if (__any((a) < 1.f)) { if (hi == 0) al_l[r32] = (a); asm volatile("s_waitcnt lgkmcnt(0)" ::: "memory"); \
    _Pragma("unroll") for (int d = 0; d < 4; ++d) _Pragma("unroll") for (int r = 0; r < 16; ++r) o[d][r] *= al_l[crow(r, hi)]; } } while (0)
    f32x16 pA0, pA1; float alA; bf16x8 pa0, pa1, pa2, pa3; const int NT = seq / KVBLK;
#define WBAR() asm volatile("s_waitcnt lgkmcnt(0)\n\ts_barrier" ::: "memory")
    const bool lag = wid >= 4;
    SLOAD(0, 0); asm volatile("s_waitcnt vmcnt(0)" ::: "memory"); SWRITE(0, 0);
    SLOAD(1, KVBLK); SLOAD(0, 2 * KVBLK);
    __syncthreads();
    qkt(pA0, pA1, K_lds, qr, negm, r32, hi);
    partialSM(pA0, pA1, mhat, negm, alA, true); finishSM(pA0, pA1, alA, l_reg, pa0, pa1, pa2, pa3);
    SWAIT(); SWRITE(1, 1);
    SLOAD(1, 3 * KVBLK);
    SWAIT(); SWRITE(2, 0);
    __syncthreads();
    if (lag) WBAR();
    for (int j = 1; j + 1 < NT; j += 2) {
        SBAR(); __builtin_amdgcn_s_setprio(1); qkt(pA0, pA1, K_lds + (j & 3) * SHM_K, qr, negm, r32, hi); pv_d0(o, vb0 + ((j - 1) & 3) * SHM_V, pa0, pa1, pa2, pa3); __builtin_amdgcn_s_setprio(0); SBAR();
        WBAR();
        SWRITE((j + 2) & 3, 1);
        if (j + 3 < NT) SLOAD(0, (j + 3) * KVBLK);
        partialSM(pA0, pA1, mhat, negm, alA, false); RESC(alA); finishSM(pA0, pA1, alA, l_reg, pa0, pa1, pa2, pa3);
        WBAR();
        SBAR(); __builtin_amdgcn_s_setprio(1); qkt(pA0, pA1, K_lds + ((j + 1) & 3) * SHM_K, qr, negm, r32, hi); pv_d0(o, vb0 + (j & 3) * SHM_V, pa0, pa1, pa2, pa3); __builtin_amdgcn_s_setprio(0); SBAR();
        WBAR();
        if (j + 3 < NT) SWRITE((j + 3) & 3, 0);
        if (j + 4 < NT) SLOAD(1, (j + 4) * KVBLK);
        partialSM(pA0, pA1, mhat, negm, alA, false); RESC(alA); finishSM(pA0, pA1, alA, l_reg, pa0, pa1, pa2, pa3);
        WBAR();
    }
    SBAR(); __builtin_amdgcn_s_setprio(1); qkt(pA0, pA1, K_lds + ((NT - 1) & 3) * SHM_K, qr, negm, r32, hi); pv_d0(o, vb0 + ((NT - 2) & 3) * SHM_V, pa0, pa1, pa2, pa3); __builtin_amdgcn_s_setprio(0); SBAR();
    WBAR();
    partialSM(pA0, pA1, mhat, negm, alA, false); RESC(alA); finishSM(pA0, pA1, alA, l_reg, pa0, pa1, pa2, pa3);
    WBAR();
    SBAR(); pv_d0(o, vb0 + ((NT - 1) & 3) * SHM_V, pa0, pa1, pa2, pa3);
    if (!lag) WBAR();
#undef WBAR
    if (hi == 0) li_l[r32] = l_reg; asm volatile("s_waitcnt lgkmcnt(0)" ::: "memory");
#pragma unroll
    for (int r = 0; r < 16; ++r) rli[r] = __builtin_amdgcn_rcpf(li_l[crow(r, hi)]);
    asm volatile("s_waitcnt vmcnt(0) lgkmcnt(0)" ::: "memory");
    __syncthreads();
#undef SLOAD
#undef SWRITE
#undef SWAIT
#undef RESC
}
}

#define WSP(T, off) ((T*)(fresh_ptr(ws) + (off)))
#define MOD WSP(float, WS_MOD)
#define ROPE WSP(float, WS_ROPE)
#define A16 WSP(float, WS_A16)
#define WIN WSP(bf16_t, WS_WIN)
#define WATT WSP(bf16_t, WS_WATT)
#define WGLU WSP(bf16_t, WS_WGLU)
#define WO WSP(bf16_t, WS_WO)
#define WFI WSP(bf16_t, WS_WFI)
#define WFO WSP(bf16_t, WS_WFO)
#define BTS WSP(bf16_t, WS_BTS)
#define BTY WSP(bf16_t, WS_BTY)
#define Hb WSP(bf16_t, WS_H)
#define Sb WSP(float, WS_H)
#define Zb WSP(bf16_t, WS_H)
#define Qb WSP(bf16_t, WS_Q)
#define Kb WSP(bf16_t, WS_K)
#define Vb WSP(bf16_t, WS_V)
#define SSMA WSP(bf16_t, WS_SSMA)
#define GA WSP(bf16_t, WS_GA)
#define GS WSP(bf16_t, WS_GS)
#define ACT WSP(bf16_t, WS_ACT)
#define STASH (WSP(float, WS_STASH) + (size_t)bx * 65536)

__device__ __forceinline__ int dstrow(int mode, int n) {
    if (mode == 1) { if (n < 1024) { const int d = n & 63; return (n & ~63) + ((d & 31) << 1) + (d >> 5); } return n; }
    if (mode == 2) { const int c = n < 1024 ? n : n - 1024; return 256 * (c >> 7) + (n < 1024 ? 0 : 128) + (c & 127); }
    if (mode == 3) { const int c = n < DFF ? n : n - DFF; return 256 * (c >> 7) + (n < DFF ? 0 : 128) + (c & 127); }
    return n;
}
__device__ __forceinline__ void transpose_item(const float* __restrict__ W, int K, int N, bf16_t* __restrict__ WT, int mode, LAS float* scr, int item, int lane) {
    const int nblk = N / 32, kb = item / nblk, nb = item % nblk, k0 = 64 * kb, n0 = 32 * nb;
#pragma unroll 8
    for (int i = 0; i < 32; ++i) { const int kk = 2 * i + (lane >> 5); scr[kk * 33 + (lane & 31)] = W[(size_t)(k0 + kk) * N + n0 + (lane & 31)]; }
    asm volatile("s_waitcnt lgkmcnt(0)" ::: "memory");
    const int c = lane & 7;
#pragma unroll
    for (int j = 0; j < 4; ++j) { const int n = (lane >> 3) + 8 * j; const LAS float* s = scr + (8 * c) * 33 + n;
        u32x4 o; o.x = cvt_pk_bf16(s[0 * 33], s[1 * 33]); o.y = cvt_pk_bf16(s[2 * 33], s[3 * 33]); o.z = cvt_pk_bf16(s[4 * 33], s[5 * 33]); o.w = cvt_pk_bf16(s[6 * 33], s[7 * 33]);
        *(u32x4*)(WT + (size_t)dstrow(mode, n0 + n) * K + k0 + 8 * c) = o; }
    asm volatile("s_waitcnt lgkmcnt(0)" ::: "memory");
}

__device__ __forceinline__ void convert_job(const Args& a, unsigned char* ws, int l, int mask, LAS unsigned char* lds, int wave, int cw, int ncw) {
    const int lane = fresh_lane();
    LAS float* scr = (LAS float*)(lds + wave * 16384);
    constexpr int I_IN = 16 * 128, I_AT = 8 * 32, I_GL = 8 * 64, I_WO = 16 * 32, I_FI = 16 * 176, I_FO = 44 * 32;
    if (mask & 1) for (int r = cw; r < I_IN; r += ncw) transpose_item(a.in[7] + (size_t)l * 1024 * 4096, 1024, 4096, WIN, 1, scr, r, lane);
    if (mask & 2) for (int it = cw; it < I_AT + I_GL + I_WO; it += ncw) { int r = it;
        if (r < I_AT) { transpose_item(a.in[13] + (size_t)l * 512 * 1024, 512, 1024, WATT, 0, scr, r, lane); continue; } r -= I_AT;
        if (r < I_GL) { transpose_item(a.in[22] + (size_t)l * 512 * 2048, 512, 2048, WGLU, 2, scr, r, lane); continue; } r -= I_GL;
        transpose_item(a.in[24] + (size_t)l * 1024 * 1024, 1024, 1024, WO, 0, scr, r, lane); }
    if (mask & 4) for (int it = cw; it < I_FI + I_FO; it += ncw) { int r = it;
        if (r < I_FI) { transpose_item(a.in[26] + (size_t)l * 1024 * 5632, 1024, 5632, WFI, 3, scr, r, lane); continue; } r -= I_FI;
        transpose_item(a.in[27] + (size_t)l * 2816 * 1024, 2816, 1024, WFO, 0, scr, r, lane); }
}

__device__ __forceinline__ void ssm_gen(const Args& a, int l, int g, LAS float* L, bf16_t* bts_, bf16_t* bty_, float* a16_, int wave) {
    const int tid = fresh_tid(wave);
    LAS float* Ap = L; LAS float* Bb = L + 4352; LAS float* Cc = Bb + 4096; LAS float* Kt = Cc + 4096;
    const float* a_re = a.in[14]; const float* a_im = a.in[15]; const float* log_dt = a.in[16];
    const float* b_re = a.in[17]; const float* b_im = a.in[18]; const float* c_re = a.in[19]; const float* c_im = a.in[20];
    if (tid < 128) {
        const int dir = tid >> 6, p = tid & 63; const int gi = (l * 2 + dir) * 32 + g;
        const float dt = expf(log_dt[gi]), ar = a_re[gi * 64 + p], ai = a_im[gi * 64 + p];
        const float mag = expf(dt * ar), abr = mag * cosf(dt * ai), abi = mag * sinf(dt * ai);
        const float nr = abr - 1.0f, ni = abi, den = ar * ar + ai * ai;
        const float fr = (nr * ar + ni * ai) / den, fi = (ni * ar - nr * ai) / den;
        float pr = 1.f, pi = 0.f; asm volatile("" : "+v"(pr), "+v"(pi));
        for (int j = 0; j <= 16; ++j) { Ap[((dir * 17 + j) * 64 + p) * 2] = pr; Ap[((dir * 17 + j) * 64 + p) * 2 + 1] = pi; const float t = pr * abr - pi * abi; pi = pr * abi + pi * abr; pr = t; }
        a16_[((g * 2 + dir) * 64 + p) * 2] = Ap[((dir * 17 + 16) * 64 + p) * 2]; a16_[((g * 2 + dir) * 64 + p) * 2 + 1] = Ap[((dir * 17 + 16) * 64 + p) * 2 + 1];
        for (int c = 0; c < 16; ++c) { const float br = b_re[((size_t)gi * 64 + p) * 16 + c], bi = b_im[((size_t)gi * 64 + p) * 16 + c];
            Bb[((dir * 64 + p) * 16 + c) * 2] = fr * br - fi * bi; Bb[((dir * 64 + p) * 16 + c) * 2 + 1] = fr * bi + fi * br; }
    }
    for (int i = tid; i < 2048; i += NTHREADS) { const int dir = i >> 10, cp = i & 1023; const int gi = (l * 2 + dir) * 32 + g;
        Cc[i * 2] = c_re[(size_t)gi * 1024 + cp]; Cc[i * 2 + 1] = c_im[(size_t)gi * 1024 + cp]; }
    __syncthreads();
    for (int idx = tid; idx < 8192; idx += NTHREADS) {
        const int cp = idx & 15, c = (idx >> 4) & 15, j = (idx >> 8) & 15, dir = idx >> 12; float s = 0.f;
        for (int p = 0; p < 64; ++p) {
            const float cr = Cc[((dir * 16 + c) * 64 + p) * 2], ci = Cc[((dir * 16 + c) * 64 + p) * 2 + 1];
            const float pr = Ap[((dir * 17 + j) * 64 + p) * 2], pi = Ap[((dir * 17 + j) * 64 + p) * 2 + 1];
            const float br = Bb[((dir * 64 + p) * 16 + cp) * 2], bi = Bb[((dir * 64 + p) * 16 + cp) * 2 + 1];
            const float car = cr * pr - ci * pi, cai = cr * pi + ci * pr;
            s += car * br - cai * bi;
        }
        Kt[idx] = s;
    }
    __syncthreads();
    for (int ch = tid; ch < 256 * 32; ch += NTHREADS) {
        const int n = ch >> 5, k0 = (ch & 31) * 8; const int dir = n >> 7, ri = (n >> 6) & 1, p = n & 63; float v[8];
#pragma unroll
        for (int e = 0; e < 8; ++e) { const int k = k0 + e, sg = k >> 4, c = k & 15, ex = dir ? sg : 15 - sg;
            const float pr = Ap[((dir * 17 + ex) * 64 + p) * 2], pi = Ap[((dir * 17 + ex) * 64 + p) * 2 + 1], br = Bb[((dir * 64 + p) * 16 + c) * 2], bi = Bb[((dir * 64 + p) * 16 + c) * 2 + 1];
            v[e] = ri ? (pr * bi + pi * br) : (pr * br - pi * bi); }
        u32x4 w; w.x = cvt_pk_bf16(v[0], v[1]); w.y = cvt_pk_bf16(v[2], v[3]); w.z = cvt_pk_bf16(v[4], v[5]); w.w = cvt_pk_bf16(v[6], v[7]);
        *(u32x4*)(bts_ + ((size_t)g * 256 + n) * 256 + k0) = w;
    }
    for (int ch = tid; ch < 256 * 64; ch += NTHREADS) {
        const int n = ch >> 6, k0 = (ch & 63) * 8; const int tau = n >> 4, c = n & 15; float v[8];
#pragma unroll
        for (int e = 0; e < 8; ++e) { const int k = k0 + e; float x;
            if (k < 256) { const int sg = k >> 4, cp = k & 15; x = 0.f;
                if (sg <= tau) x += Kt[((0 * 16 + (tau - sg)) * 16 + c) * 16 + cp];
                if (sg >= tau) x += Kt[((1 * 16 + (sg - tau)) * 16 + c) * 16 + cp];
            } else { const int kk = k - 256, dir = kk >> 7, ri = (kk >> 6) & 1, p = kk & 63, ex = dir ? 16 - tau : tau + 1;
                const float cr = Cc[((dir * 16 + c) * 64 + p) * 2], ci = Cc[((dir * 16 + c) * 64 + p) * 2 + 1], pr = Ap[((dir * 17 + ex) * 64 + p) * 2], pi = Ap[((dir * 17 + ex) * 64 + p) * 2 + 1];
                x = ri ? -(cr * pi + ci * pr) : (cr * pr - ci * pi); }
            v[e] = x; }
        u32x4 w; w.x = cvt_pk_bf16(v[0], v[1]); w.y = cvt_pk_bf16(v[2], v[3]); w.z = cvt_pk_bf16(v[4], v[5]); w.w = cvt_pk_bf16(v[6], v[7]);
        *(u32x4*)(bty_ + ((size_t)g * 256 + n) * 512 + k0) = w;
    }
    __syncthreads();
}

__device__ __forceinline__ void norm_rows(const float* __restrict__ x, bf16_t* __restrict__ H, const float* __restrict__ gam, const float* __restrict__ modl  ,
                                          int sh_off, int sc_off, int Lshift, int gw, int NGW, int lane_in) {
    const int lane = fresh_lane(); (void)lane_in;
    const int nb = MG >> Lshift, wpb = NGW / nb;
    if (wpb * nb == NGW && ((1 << Lshift) % (4 * wpb)) == 0) {
        const int b = gw / wpb, r0 = gw % wpb, L = 1 << Lshift;
        const float* mb = modl + (size_t)b * 6144;
        f32x4 gm[4], sh[4];
#pragma unroll
        for (int j = 0; j < 4; ++j) { const f32x4 g4 = *(const f32x4*)(gam + 4 * lane + 256 * j), sc = *(const f32x4*)(mb + sc_off + 4 * lane + 256 * j);
            gm[j] = g4 * (sc + 1.0f); sh[j] = *(const f32x4*)(mb + sh_off + 4 * lane + 256 * j); }
        const float* xb = x + (size_t)b * L * D; bf16_t* hb = H + (size_t)b * L * D;
        for (int r = r0; r < L; r += 4 * wpb) {
            f32x4 v[4][4]; float s[4];
#pragma unroll
            for (int q = 0; q < 4; ++q) { const f32x4* xr = (const f32x4*)(xb + (size_t)(r + q * wpb) * D) + lane;
#pragma unroll
                for (int j = 0; j < 4; ++j) v[q][j] = __builtin_nontemporal_load(&xr[64 * j]); }
#pragma unroll
            for (int q = 0; q < 4; ++q) { float t = 0.f;
#pragma unroll
                for (int j = 0; j < 4; ++j) t += (v[q][j].x * v[q][j].x + v[q][j].y * v[q][j].y) + (v[q][j].z * v[q][j].z + v[q][j].w * v[q][j].w);
                s[q] = rsqrtf(wave_sum(t) * (1.f / D) + EPS); }
#pragma unroll
            for (int q = 0; q < 4; ++q) {
                u32x2* o = (u32x2*)(hb + (size_t)(r + q * wpb) * D) + lane;
#pragma unroll
                for (int j = 0; j < 4; ++j) { const f32x4 h = v[q][j] * s[q] * gm[j] + sh[j];
                    u32x2 w; w.x = cvt_pk_bf16(h[0], h[1]); w.y = cvt_pk_bf16(h[2], h[3]); o[64 * j] = w; }
            }
        }
        return;
    }
    f32x4 gv[4];
#pragma unroll
    for (int j = 0; j < 4; ++j) gv[j] = *(const f32x4*)(gam + 4 * lane + 256 * j);
    for (int row = gw; row < MG; row += NGW) {
        const f32x4* xr = (const f32x4*)(x + (size_t)row * D) + lane;
        f32x4 v[4]; float s = 0.f;
#pragma unroll
        for (int j = 0; j < 4; ++j) { v[j] = xr[64 * j]; s += (v[j].x * v[j].x + v[j].y * v[j].y) + (v[j].z * v[j].z + v[j].w * v[j].w); }
        const float r = rsqrtf(wave_sum(s) * (1.f / D) + EPS);
        const float* mb = modl + (size_t)(row >> Lshift) * 6144;
        u32x2* o = (u32x2*)(H + (size_t)row * D) + lane;
#pragma unroll
        for (int j = 0; j < 4; ++j) {
            const f32x4 sc = *(const f32x4*)(mb + sc_off + 4 * lane + 256 * j), sh = *(const f32x4*)(mb + sh_off + 4 * lane + 256 * j);
            const f32x4 h = v[j] * r * gv[j] * (sc + 1.0f) + sh;
            u32x2 w; w.x = cvt_pk_bf16(h[0], h[1]); w.y = cvt_pk_bf16(h[2], h[3]); o[64 * j] = w;
        }
    }
}

#define XB_TMO      128
#define XB_XCNT(j)  (256  + 64 * (j))
#define XB_XSUB(j)  (1280 + 64 * (j))
#define XB_XGEN(j)  (2304 + 64 * (j))
#define XB_TOP      3328
#define XB_TOPGEN   3392
#define XCD_BAR_WORDS 3456
#define XB_SPIN_CAP (1u << 18)
__device__ __forceinline__ unsigned xb_ld(unsigned* p)              { return __hip_atomic_load(p, __ATOMIC_RELAXED, __HIP_MEMORY_SCOPE_AGENT); }
__device__ __forceinline__ unsigned xb_add(unsigned* p, unsigned v) { return __hip_atomic_fetch_add(p, v, __ATOMIC_RELAXED, __HIP_MEMORY_SCOPE_AGENT); }
__device__ __forceinline__ unsigned xb_xcc_id() { return (unsigned)__builtin_amdgcn_s_getreg((3 << 11) | 20) & 0xFu; }
#define XB_SPIN(cond, bar) do { unsigned _sp = 0; while (cond) { __builtin_amdgcn_s_sleep(1); \
    if ((++_sp & 255u) == 0u) { if (xb_ld(&(bar)[XB_TMO])) break; if (_sp > XB_SPIN_CAP) { atomicAdd(&(bar)[XB_TMO], 1u); break; } } } } while (0)
struct XcdBarrier { unsigned* bar; unsigned x; volatile LAS unsigned* st; };
__device__ __forceinline__ XcdBarrier xcd_barrier_post(unsigned* bar, volatile LAS unsigned* st) {
    XcdBarrier b; b.bar = bar; b.x = xb_xcc_id(); b.st = st;
    if (threadIdx.x == 0) (void)xb_add(&bar[XB_XCNT(b.x)], 1u);
    return b;
}
__device__ __forceinline__ void xcd_barrier_complete(unsigned* bar, unsigned x, unsigned& nloc, unsigned& nx) {
    const unsigned G = gridDim.x * gridDim.y * gridDim.z;
    unsigned sum, cnt, mine, sp = 0u;
    for (;;) {
        sum = 0u; cnt = 0u; mine = 0u;
#pragma unroll
        for (unsigned j = 0; j < 16; ++j) { const unsigned c = xb_ld(&bar[XB_XCNT(j)]); sum += c; cnt += (c > 0u) ? 1u : 0u; mine = (j == x) ? c : mine; }
        if (sum == G) break;
        __builtin_amdgcn_s_sleep(1);
        if ((++sp & 255u) == 0u) { if (xb_ld(&bar[XB_TMO])) break; if (sp > XB_SPIN_CAP) { atomicAdd(&bar[XB_TMO], 1u); break; } }
    }
    nloc = mine > 0u ? mine : 1u; nx = cnt > 0u ? cnt : 1u;
}
__device__ __forceinline__ void xcd_barrier(const XcdBarrier& b) {
    asm volatile("s_waitcnt vmcnt(0)" ::: "memory");
    __syncthreads();
    if (threadIdx.x == 0) {
        unsigned* bar = b.bar;
        __builtin_amdgcn_s_waitcnt(0);
        unsigned nloc = b.st[0], nx = b.st[1];
        if (nloc == 0u) { xcd_barrier_complete(bar, b.x, nloc, nx); b.st[0] = nloc; b.st[1] = nx; }
        const unsigned old = xb_add(&bar[XB_XSUB(b.x)], 1u);
        const unsigned gen = old / nloc;
        if (old + 1u == (gen + 1u) * nloc) {
            __builtin_amdgcn_fence(__ATOMIC_RELEASE, "agent");
            asm volatile("s_waitcnt vmcnt(0)" ::: "memory");
            const unsigned og = xb_add(&bar[XB_TOP], 1u);
            const unsigned tg = og / nx;
            if (og + 1u == (tg + 1u) * nx) xb_add(&bar[XB_TOPGEN], 1u);
            else XB_SPIN(xb_ld(&bar[XB_TOPGEN]) == tg, bar);
            __builtin_amdgcn_fence(__ATOMIC_ACQUIRE, "agent");
            xb_add(&bar[XB_XGEN(b.x)], 1u);
            asm volatile("s_waitcnt vmcnt(0)" ::: "memory");
        } else {
            XB_SPIN(xb_ld(&bar[XB_XGEN(b.x)]) == gen, bar);
            __builtin_amdgcn_fence(__ATOMIC_ACQUIRE, "agent");
            asm volatile("s_waitcnt vmcnt(0)" ::: "memory");
        }
    }
    __syncthreads();
}

__global__ void __launch_bounds__(NTHREADS, 2) mega(Args a) {
    extern __shared__ __attribute__((aligned(16))) unsigned char lds_raw[];
    LAS unsigned char* lds = (LAS unsigned char*)lds_raw;
    cg::grid_group grid = cg::this_grid();
    const int wave = __builtin_amdgcn_readfirstlane((int)threadIdx.x >> 6);
    const int G = gridDim.x, bx = blockIdx.x;
    const int vcu = (G % 8 == 0) ? (bx % 8) * (G / 8) + bx / 8 : bx;
    const int gw = bx * NWAVES + wave, NGW = G * NWAVES;
    unsigned char* ws = a.ws;
    {
        if (bx == 0) for (int i = threadIdx.x; i < XCD_BAR_WORDS; i += NTHREADS) ((unsigned*)(ws + WS_BAR))[i] = 0u;
        if (threadIdx.x < 2) ((volatile LAS unsigned*)(lds + LDS_MISC))[threadIdx.x] = 0u;
        __syncthreads();
    }

#ifndef NO_P0
    {
        const int tid = fresh_tid(wave);
        LAS float* scv = (LAS float*)lds;
        LAS float* red = (LAS float*)(lds + 49152);
        for (int item = bx; item < 192; item += G) {
            const int l = item / 48, nb = item % 48, c = tid & 127, kq = tid >> 7, n = nb * 128 + c;
            __syncthreads();
            for (int i = tid; i < 12 * 1024; i += NTHREADS) { const int b = i >> 10, k = i & 1023; const float cv = b < 8 ? a.in[2][b * 1024 + k] : a.in[3][(b - 8) * 1024 + k]; scv[k * 12 + b] = siluf_(cv); }
            __syncthreads();
            float acc[12];
#pragma unroll
            for (int b = 0; b < 12; ++b) acc[b] = 0.f;
            const float* wp = a.in[4] + (size_t)l * 1024 * 6144 + (size_t)(kq * 256) * 6144 + n;
            const LAS float* sp = scv + kq * 256 * 12;
#pragma unroll 8
            for (int k = 0; k < 256; ++k) {
                const float w = wp[(size_t)k * 6144];
                const f32x4 s0 = *(const LAS f32x4*)(sp + k * 12), s1 = *(const LAS f32x4*)(sp + k * 12 + 4), s2 = *(const LAS f32x4*)(sp + k * 12 + 8);
                acc[0] += s0[0] * w; acc[1] += s0[1] * w; acc[2] += s0[2] * w; acc[3] += s0[3] * w;
                acc[4] += s1[0] * w; acc[5] += s1[1] * w; acc[6] += s1[2] * w; acc[7] += s1[3] * w;
                acc[8] += s2[0] * w; acc[9] += s2[1] * w; acc[10] += s2[2] * w; acc[11] += s2[3] * w;
            }
#pragma unroll
            for (int b = 0; b < 12; ++b) red[(kq * 12 + b) * 128 + c] = acc[b];
            __syncthreads();
            for (int i = tid; i < 12 * 128; i += NTHREADS) { const int b = i >> 7, cc = i & 127;
                const float v = ((red[(0 * 12 + b) * 128 + cc] + red[(1 * 12 + b) * 128 + cc]) + red[(2 * 12 + b) * 128 + cc]) + red[(3 * 12 + b) * 128 + cc];
                MOD[((size_t)l * 12 + b) * 6144 + nb * 128 + cc] = v + a.in[5][l * 6144 + nb * 128 + cc]; }
        }
        for (int i = bx * NTHREADS + tid; i < 8192 * 32; i += G * NTHREADS) {
            const int pos = i >> 5, fi = i & 31; const float inv = 1.0f / powf(10000.0f, (float)fi * (1.0f / 32.0f)); const float ang = (float)pos * inv;
            ROPE[(size_t)i * 2] = cosf(ang); ROPE[(size_t)i * 2 + 1] = sinf(ang);
        }
    }
#endif
    grid.sync();
    const XcdBarrier xbar = xcd_barrier_post((unsigned*)(ws + WS_BAR), (volatile LAS unsigned*)(lds + LDS_MISC));

    for (int l = 0; l < DEPTH; ++l) {
        for (int grp = 0; grp < 2; ++grp) {
            float* xg = a.out + (size_t)grp * MG * D;
            const int Lshift = grp ? 13 : 12, L = 1 << Lshift, bbase = grp ? 8 : 0, nbat = grp ? 4 : 8, NC = L >> 4;
            const float* modl = MOD + ((size_t)l * 12 + bbase) * 6144;

            if (l == 0 && grp == 0) {
                if (bx < 32) { for (int g = bx; g < 32; g += G) ssm_gen(a, 0, g, (LAS float*)lds, BTS, BTY, A16, wave); }
                else convert_job(a, ws, 0, 3, lds, wave, (bx - 32) * NWAVES + wave, (G - 32) * NWAVES);
            }
            norm_rows(l == 0 ? a.in[grp] : xg, Hb, a.in[6] + l * 1024, modl, 0, 1024, Lshift, gw, NGW, 0);
            xcd_barrier(xbar);

#ifndef NO_P2
            {
                pg8::GridOrder S; S.init(MG, INCOLS, G, bx, Hb, WIN, 1024, 1024);
                EpiInproj E{Qb, Kb, Vb, SSMA, GA, GS, ROPE, L - 1};
                pg8::gemm_phase(lds, wave, 1024, 1024, 1024, S, E);
            }
#endif
            xcd_barrier(xbar);

#ifndef NO_P3
            {
                pg8::SsmOrder S{(const char*)SSMA, (const char*)BTS, (size_t)256 * 256 * 2, G, vcu};
                EpiS E{Sb};
                pg8::gemm_phase(lds, wave, 256, 512, 256, S, E);
            }
#endif
            xcd_barrier(xbar);

#ifndef NO_P4
            {
                const int nitem = nbat * 64;
                const int lane = fresh_lane();
                for (int it = wave * G + bx; it < nitem; it += NGW) {
                    const int dir = it & 1, g = (it >> 1) & 31, b = it >> 6;
                    const float ar = A16[((g * 2 + dir) * 64 + lane) * 2], ai = A16[((g * 2 + dir) * 64 + lane) * 2 + 1];
                    float hr = 0.f, hi = 0.f;
                    const size_t rbase = (size_t)g * NROW + (size_t)b * NC;
                    for (int c0 = 0; c0 < NC; c0 += 16) {
                        float sr[16], si[16];
#pragma unroll
                        for (int e = 0; e < 16; ++e) { const int c = dir ? NC - 1 - (c0 + e) : c0 + e; const float* sp = Sb + (rbase + c) * 256 + dir * 128 + lane; sr[e] = sp[0]; si[e] = sp[64]; }
#pragma unroll
                        for (int e = 0; e < 16; ++e) { const int c = dir ? NC - 1 - (c0 + e) : c0 + e; bf16_t* hp = SSMA + (rbase + c) * 512 + 256 + dir * 128 + lane;
                            hp[0] = (bf16_t)(cvt_pk_bf16(hr, 0.f) & 0xffffu); hp[64] = (bf16_t)(cvt_pk_bf16(hi, 0.f) & 0xffffu);
                            const float t = ar * hr - ai * hi + sr[e]; hi = ar * hi + ai * hr + si[e]; hr = t; }
                    }
                }
                if (wave >= 2) {
                    if (grp == 0) convert_job(a, ws, l, 4, lds, wave, bx * 6 + wave - 2, G * 6);
                    else if (l + 1 < DEPTH) convert_job(a, ws, l + 1, 1, lds, wave, bx * 6 + wave - 2, G * 6);
                }
            }
#endif
            xcd_barrier(xbar);

#ifndef NO_P5
            {
                const float lam_init = __uint_as_float(__builtin_amdgcn_readfirstlane(l == 0 ? 0x3e4ccccdu : l == 1 ? 0x3eb60549u : l == 2 ? 0x3ef1014cu : 0x3f0e59d5u));
                float lam;
                { const int lane = fresh_lane();
                  const float q1 = a.in[8][l * 64 + lane] * a.in[9][l * 64 + lane], q2 = a.in[10][l * 64 + lane] * a.in[11][l * 64 + lane];
                  lam = expf(wave_sum(q1)) - expf(wave_sum(q2)) + lam_init; }
                const int NQB = L >> 8;
#ifndef NO_P5A
                for (int unit = vcu; unit < 512; unit += G) {
                    const int bh = unit / NQB, qb = unit % NQB, b = bh >> 2, h = bh & 3;
                    const size_t row0 = (size_t)b * L + (size_t)qb * 256;
                    f32x16 o[4]; float rli[16];
                    att::attn_pass(Qb + row0 * 512 + h * 128, Kb + (size_t)b * L * 512 + h * 128, Vb + (size_t)b * L * 512 + h * 128, L, (LAS char*)lds, wave, o, rli);
                    {
                        f32x4* p = (f32x4*)STASH + (size_t)wave * 1024 + (fresh_lane());
#pragma unroll
                        for (int d0 = 0; d0 < 4; ++d0)
#pragma unroll
                            for (int r4 = 0; r4 < 4; ++r4) {
                                f32x4 v; v[0] = o[d0][4 * r4] * rli[4 * r4]; v[1] = o[d0][4 * r4 + 1] * rli[4 * r4 + 1]; v[2] = o[d0][4 * r4 + 2] * rli[4 * r4 + 2]; v[3] = o[d0][4 * r4 + 3] * rli[4 * r4 + 3];
                                p[(d0 * 4 + r4) * 64] = v; }
                    }
                    att::attn_pass(Qb + row0 * 512 + h * 128 + 64, Kb + (size_t)b * L * 512 + h * 128 + 64, Vb + (size_t)b * L * 512 + h * 128, L, (LAS char*)lds, wave, o, rli);
                    const int lane = fresh_lane(), r32 = lane & 31, hi = lane >> 5;
                    float ss[16];
#pragma unroll
                    for (int r = 0; r < 16; ++r) ss[r] = 0.f;
                    {
                        const f32x4* p = (const f32x4*)STASH + (size_t)wave * 1024 + lane;
#pragma unroll
                        for (int d0 = 0; d0 < 4; ++d0)
#pragma unroll
                            for (int r4 = 0; r4 < 4; ++r4) { const f32x4 t = p[(d0 * 4 + r4) * 64];
#pragma unroll
                                for (int e = 0; e < 4; ++e) { const int r = 4 * r4 + e; const float v = t[e] - lam * (o[d0][r] * rli[r]); o[d0][r] = v; ss[r] += v * v; } }
                    }
                    float sg[4];
#pragma unroll
                    for (int d0 = 0; d0 < 4; ++d0) sg[d0] = a.in[12][l * 128 + d0 * 32 + r32] * (1.0f - lam_init);
#pragma unroll
                    for (int r = 0; r < 16; ++r) {
                        float s = ss[r];
                        s = half_sum(s);
                        const float rs = rsqrtf(s * (1.0f / 128.0f) + EPS);
                        bf16_t* op = Qb + (row0 + wave * 32 + att::crow(r, hi)) * 512 + h * 128 + r32;
#pragma unroll
                        for (int d0 = 0; d0 < 4; ++d0) op[d0 * 32] = (bf16_t)(cvt_pk_bf16(o[d0][r] * rs * sg[d0], 0.f) & 0xffffu);
                    }
                }
#endif
                __syncthreads();
#ifndef NO_P5Y
                pg8::SsmOrder S{(const char*)SSMA, (const char*)BTY, (size_t)256 * 512 * 2, G, vcu};
                EpiY E{SSMA, Zb, a.in[21] + l * 512};
                pg8::gemm_phase(lds, wave, 512, 512, 512, S, E);
#endif
            }
#endif
            xcd_barrier(xbar);

#ifndef NO_P6
            {
                pg8::MergeOrder S{(const char*)Zb, (const char*)Qb, (const char*)WGLU, (const char*)WATT, G, vcu};
                EpiMerge E{GA, GS, a.in[23] + l * 2048};
                pg8::gemm_phase(lds, wave, 512, 512, 512, S, E);
            }
#endif
            xcd_barrier(xbar);

#ifndef NO_P7
            {
                pg8::GridOrder S; S.init(MG, D, G, bx, GA, WO, 1024, 1024);
                EpiResid E{l == 0 ? a.in[grp] : xg, xg, modl + 2048, Lshift};
                pg8::gemm_phase(lds, wave, 1024, 1024, 1024, S, E);
            }
#endif
            xcd_barrier(xbar);

            if (grp == 1 && l + 1 < DEPTH) {
                if (bx < 32) { for (int g = bx; g < 32; g += G) ssm_gen(a, l + 1, g, (LAS float*)lds, BTS, BTY, A16, wave); }
                else convert_job(a, ws, l + 1, 2, lds, wave, (bx - 32) * NWAVES + wave, (G - 32) * NWAVES);
            }
            norm_rows(xg, Hb, a.in[25] + l * 1024, modl, 3072, 4096, Lshift, gw, NGW, 0);
            xcd_barrier(xbar);

#ifndef NO_P9
            {
                pg8::GridOrder S; S.init(MG, 2 * DFF, G, bx, Hb, WFI, 1024, 1024);
                EpiFfnIn E{ACT};
                pg8::gemm_phase(lds, wave, 1024, 1024, 1024, S, E);
            }
#endif
            xcd_barrier(xbar);

#ifndef NO_P10
            {
                pg8::GridOrder S; S.init(MG, D, G, bx, ACT, WFO, DFF, DFF);
                EpiResid E{xg, xg, modl + 5120, Lshift};
                pg8::gemm_phase(lds, wave, DFF, DFF, DFF, S, E);
            }
#endif
            xcd_barrier(xbar);
        }
    }

    {
        const int lane = fresh_lane();
        f32x4 gv[4];
#pragma unroll
        for (int j = 0; j < 4; ++j) gv[j] = *(const f32x4*)(a.in[28] + 4 * lane + 256 * j);
        for (int row = gw; row < 2 * MG; row += 4 * NGW) {
            f32x4 v[4][4]; float sc[4];
#pragma unroll
            for (int q = 0; q < 4; ++q) { const int r = row + q * NGW < 2 * MG ? row + q * NGW : row; const f32x4* xr = (const f32x4*)(a.out + (size_t)r * D) + lane;
#pragma unroll
                for (int j = 0; j < 4; ++j) v[q][j] = __builtin_nontemporal_load(&xr[64 * j]); }
#pragma unroll
            for (int q = 0; q < 4; ++q) { float t = 0.f;
#pragma unroll
                for (int j = 0; j < 4; ++j) t += (v[q][j].x * v[q][j].x + v[q][j].y * v[q][j].y) + (v[q][j].z * v[q][j].z + v[q][j].w * v[q][j].w);
                sc[q] = rsqrtf(wave_sum(t) * (1.f / D) + EPS); }
#pragma unroll
            for (int q = 0; q < 4; ++q) { if (row + q * NGW < 2 * MG) { f32x4* xr = (f32x4*)(a.out + (size_t)(row + q * NGW) * D) + lane;
#pragma unroll
                for (int j = 0; j < 4; ++j) __builtin_nontemporal_store(v[q][j] * sc[q] * gv[j], &xr[64 * j]); } }
        }
    }
}

extern "C" void kernel_launch(void* const* d_in, const int* in_sizes, int n_in, void* d_out, int out_size, void* d_ws, size_t ws_size, hipStream_t stream) {
    static int grid = 0;
    if (grid == 0) {
        if (n_in != 29 || out_size != 2 * MG * D || ws_size < WS_END) { fprintf(stderr, "kernel_launch: unexpected shapes (n_in %d out %d ws %zu)\n", n_in, out_size, ws_size); grid = -1; return; }
        int dev = 0, cus = 0, per_cu = 0;
        if (hipGetDevice(&dev) != hipSuccess || hipDeviceGetAttribute(&cus, hipDeviceAttributeMultiprocessorCount, dev) != hipSuccess) { grid = -1; return; }
        if (hipFuncSetAttribute((const void*)mega, hipFuncAttributeMaxDynamicSharedMemorySize, LDS_BYTES) != hipSuccess) { fprintf(stderr, "kernel_launch: hipFuncSetAttribute failed\n"); grid = -1; return; }
        if (hipOccupancyMaxActiveBlocksPerMultiprocessor(&per_cu, (const void*)mega, NTHREADS, LDS_BYTES) != hipSuccess || per_cu < 1) { fprintf(stderr, "kernel_launch: occupancy query gave %d\n", per_cu); per_cu = 1; }
        (void)hipGetLastError();
        grid = cus * per_cu;
    }
    if (grid < 0) return;
    Args a{};
    for (int i = 0; i < 29; ++i) a.in[i] = (const float*)d_in[i];
    a.out = (float*)d_out; a.ws = (unsigned char*)d_ws;
    void* args[] = {&a};
    const hipError_t e = hipLaunchCooperativeKernel((const void*)mega, dim3(grid), dim3(NTHREADS), args, LDS_BYTES, stream);
    if (e != hipSuccess) fprintf(stderr, "kernel_launch: cooperative launch failed: %s (grid %d)\n", hipGetErrorString(e), grid);
}
```
